# Optimizing an MI355X kernel written in HIP

```python
import jax, jax.numpy as jnp
from jax import lax
import numpy as np

D_MODEL = 2048
BATCH = 2
SEQ = 8192
DEPTH = 4

N_A_LAYERS = DEPTH // 2
N_B_LAYERS = DEPTH - N_A_LAYERS
D_PLE = 256
D_FF = 5504
MLSTM_HEADS = 4
MLSTM_DQK = D_MODEL // (2 * MLSTM_HEADS)
MLSTM_DV = D_MODEL // MLSTM_HEADS
MLSTM_CHUNK = 64
MLSTM_PROJ = 2 * MLSTM_HEADS * MLSTM_DQK + 2 * MLSTM_HEADS * MLSTM_DV + 2 * MLSTM_HEADS
FORGET_BIAS_OFFSET = 3.0
SB_HEADS = 16
SB_HEAD_DIM = D_MODEL // SB_HEADS
SB_BLOCK = 128
RMS_EPS = 1e-6

kernel_name = "yoco_mlstm_stickbreaking_macaron"


def rmsnorm(x, g):
    xf = x.astype(jnp.float32)
    y = xf * lax.rsqrt(jnp.mean(xf * xf, axis=-1, keepdims=True) + RMS_EPS)
    return (y * g.astype(jnp.float32)).astype(x.dtype)


def swiglu(x, w_gate, w_up, w_down):
    return (jax.nn.silu(x @ w_gate) * (x @ w_up)) @ w_down


def mlstm_mixer(h, w_in, b_if, g_head, w_out):
    B, S, _ = h.shape
    H, dk, dv, L = MLSTM_HEADS, MLSTM_DQK, MLSTM_DV, MLSTM_CHUNK
    NC = S // L
    proj = (h @ w_in).astype(jnp.float32)
    o1 = H * dk; o2 = 2 * H * dk; o3 = o2 + H * dv; o4 = o3 + H * dv; o5 = o4 + H
    q, k, v, og, gi, gf = jnp.split(proj, [o1, o2, o3, o4, o5], axis=-1)
    b_if = b_if.astype(jnp.float32)
    log_i = gi + b_if[:H]
    log_f = jax.nn.log_sigmoid(gf + b_if[H:])
    q = q * (dk ** -0.5)

    def to_chunks(t, d):
        return t.reshape(B, NC, L, H, d).transpose(1, 0, 3, 2, 4)

    def gate_chunks(t):
        return t.reshape(B, NC, L, H).transpose(1, 0, 3, 2)

    xs = (to_chunks(q, dk), to_chunks(k, dk), to_chunks(v, dv), gate_chunks(log_i), gate_chunks(log_f))
    causal = jnp.tril(jnp.ones((L, L), dtype=bool))

    def chunk_step(carry, inp):
        C, n, m = carry
        qc, kc, vc, ic, fc = inp
        b = jnp.cumsum(fc, axis=-1)
        a = b + m[..., None]
        Dm = jnp.where(causal, b[..., :, None] - b[..., None, :] + ic[..., None, :], -jnp.inf)
        m_t = jnp.maximum(a, jnp.max(Dm, axis=-1))
        w_inter = jnp.exp(a - m_t)
        s_qk = jnp.einsum('bhtd,bhsd->bhts', qc, kc) * jnp.exp(Dm - m_t[..., None])
        num = w_inter[..., None] * jnp.einsum('bhtd,bhde->bhte', qc, C) + jnp.einsum('bhts,bhse->bhte', s_qk, vc)
        den = w_inter * jnp.einsum('bhtd,bhd->bht', qc, n) + jnp.sum(s_qk, axis=-1)
        h_out = num / jnp.maximum(jnp.abs(den), jnp.exp(-m_t))[..., None]
        bL = b[..., -1]
        g_end = bL[..., None] - b + ic
        m_new = jnp.maximum(bL + m, jnp.max(g_end, axis=-1))
        decay = jnp.exp(bL + m - m_new)
        w_end = jnp.exp(g_end - m_new[..., None])
        C_new = decay[..., None, None] * C + jnp.einsum('bhs,bhsd,bhse->bhde', w_end, kc, vc)
        n_new = decay[..., None] * n + jnp.einsum('bhs,bhsd->bhd', w_end, kc)
        return (C_new, n_new, m_new), h_out

    init = (jnp.zeros((B, H, dk, dv), jnp.float32), jnp.zeros((B, H, dk), jnp.float32), jnp.zeros((B, H), jnp.float32))
    _, hs = lax.scan(chunk_step, init, xs)
    hs = hs.transpose(1, 0, 3, 2, 4).reshape(B, S, H, dv)
    hs = rmsnorm(hs, g_head.reshape(H, dv)).reshape(B, S, H * dv)
    hs = hs * jax.nn.sigmoid(og)
    return hs.astype(h.dtype) @ w_out


def shared_kv(h, g_kv, w_kv, g_k):
    B, S, _ = h.shape
    kv = (rmsnorm(h, g_kv) @ w_kv).astype(jnp.float32)
    k, v = jnp.split(kv, 2, axis=-1)
    k = rmsnorm(k.reshape(B, S, SB_HEADS, SB_HEAD_DIM), g_k)
    v = v.reshape(B, S, SB_HEADS, SB_HEAD_DIM)
    return k.transpose(0, 2, 1, 3), v.transpose(0, 2, 1, 3)


def stick_breaking_mixer(h, w_q, g_q, w_o, k, v):
    B, S, _ = h.shape
    q = (h @ w_q).astype(jnp.float32).reshape(B, S, SB_HEADS, SB_HEAD_DIM)
    q = (rmsnorm(q, g_q) * (SB_HEAD_DIM ** -0.5)).transpose(0, 2, 1, 3)
    outs = []
    for blk in range(S // SB_BLOCK):
        t0 = blk * SB_BLOCK
        kn = t0 + SB_BLOCK
        z = jnp.einsum('bhtd,bhsd->bhts', q[:, :, t0:kn], k[:, :, :kn])
        mask = jnp.arange(kn)[None, :] < (t0 + jnp.arange(SB_BLOCK))[:, None]
        log_beta = jax.nn.log_sigmoid(z)
        log_keep = jnp.where(mask, jax.nn.log_sigmoid(-z), 0.0)
        after = lax.cumsum(log_keep, axis=log_keep.ndim - 1, reverse=True) - log_keep
        A = jnp.where(mask, jnp.exp(log_beta + after), 0.0)
        outs.append(jnp.einsum('bhts,bhsd->bhtd', A, v[:, :, :kn]))
    o = jnp.concatenate(outs, axis=2).transpose(0, 2, 1, 3).reshape(B, S, SB_HEADS * SB_HEAD_DIM)
    return o.astype(h.dtype) @ w_o


def per_layer_embedding(h, p_i, g, w_proj, w_gate):
    gate = jax.nn.sigmoid(rmsnorm(h, g) @ w_gate)
    return h + (p_i.astype(h.dtype) @ w_proj) * gate


def setup_inputs(seed: int = 0) -> dict:
    key = jax.random.key(seed)
    ks = jax.random.split(key, 24)
    f32 = jnp.float32

    def nrm(k, shape, scale):
        return jax.random.normal(k, shape, f32) * scale

    def gain(k, shape):
        return 1.0 + 0.02 * jax.random.normal(k, shape, f32)

    H = MLSTM_HEADS
    b_i = 0.1 * jax.random.normal(ks[8], (N_A_LAYERS, H), f32)
    b_f = FORGET_BIAS_OFFSET + 0.1 * jax.random.normal(ks[9], (N_A_LAYERS, H), f32)
    return {
        "x": nrm(ks[0], (BATCH, SEQ, D_MODEL), 1.0),
        "p": nrm(ks[1], (DEPTH, BATCH, SEQ, D_PLE), 1.0),
        "ffn_norm": gain(ks[2], (DEPTH, 2, D_MODEL)),
        "ffn_w_gate": nrm(ks[3], (DEPTH, 2, D_MODEL, D_FF), D_MODEL ** -0.5),
        "ffn_w_up": nrm(ks[4], (DEPTH, 2, D_MODEL, D_FF), D_MODEL ** -0.5),
        "ffn_w_down": nrm(ks[5], (DEPTH, 2, D_FF, D_MODEL), D_FF ** -0.5),
        "mix_norm": gain(ks[6], (DEPTH, D_MODEL)),
        "mlstm_w_in": nrm(ks[7], (N_A_LAYERS, D_MODEL, MLSTM_PROJ), D_MODEL ** -0.5),
        "mlstm_b_if": jnp.concatenate([b_i, b_f], axis=-1),
        "mlstm_head_norm": gain(ks[10], (N_A_LAYERS, H * MLSTM_DV)),
        "mlstm_w_out": nrm(ks[11], (N_A_LAYERS, H * MLSTM_DV, D_MODEL), (H * MLSTM_DV) ** -0.5),
        "kv_norm": gain(ks[12], (D_MODEL,)),
        "sb_w_kv": nrm(ks[13], (D_MODEL, 2 * SB_HEADS * SB_HEAD_DIM), D_MODEL ** -0.5),
        "sb_k_norm": gain(ks[14], (SB_HEAD_DIM,)),
        "sb_w_q": nrm(ks[15], (N_B_LAYERS, D_MODEL, SB_HEADS * SB_HEAD_DIM), D_MODEL ** -0.5),
        "sb_q_norm": gain(ks[16], (N_B_LAYERS, SB_HEAD_DIM)),
        "sb_w_o": nrm(ks[17], (N_B_LAYERS, SB_HEADS * SB_HEAD_DIM, D_MODEL), (SB_HEADS * SB_HEAD_DIM) ** -0.5),
        "ple_norm": gain(ks[18], (DEPTH, D_MODEL)),
        "ple_w_proj": nrm(ks[19], (DEPTH, D_PLE, D_MODEL), D_PLE ** -0.5),
        "ple_w_gate": nrm(ks[20], (DEPTH, D_MODEL, D_MODEL), D_MODEL ** -0.5),
    }


def reference(x, p, ffn_norm, ffn_w_gate, ffn_w_up, ffn_w_down, mix_norm,
              mlstm_w_in, mlstm_b_if, mlstm_head_norm, mlstm_w_out,
              kv_norm, sb_w_kv, sb_k_norm, sb_w_q, sb_q_norm, sb_w_o,
              ple_norm, ple_w_proj, ple_w_gate):
    h = x
    k_sh = None
    v_sh = None
    for i in range(DEPTH):
        if i == N_A_LAYERS:
            k_sh, v_sh = shared_kv(h, kv_norm, sb_w_kv, sb_k_norm)
        h = h + 0.5 * swiglu(rmsnorm(h, ffn_norm[i, 0]), ffn_w_gate[i, 0], ffn_w_up[i, 0], ffn_w_down[i, 0])
        hn = rmsnorm(h, mix_norm[i])
        if i < N_A_LAYERS:
            h = h + mlstm_mixer(hn, mlstm_w_in[i], mlstm_b_if[i], mlstm_head_norm[i], mlstm_w_out[i])
        else:
            j = i - N_A_LAYERS
            h = h + stick_breaking_mixer(hn, sb_w_q[j], sb_q_norm[j], sb_w_o[j], k_sh, v_sh)
        h = h + 0.5 * swiglu(rmsnorm(h, ffn_norm[i, 1]), ffn_w_gate[i, 1], ffn_w_up[i, 1], ffn_w_down[i, 1])
        h = per_layer_embedding(h, p[i], ple_norm[i], ple_w_proj[i], ple_w_gate[i])
    return h
```

```cpp
#define TIER_FFN 1
#define TIER_MLSTM 1
#define TIER_SB 1
#define TIER_PLE 1
#define F_PER_PHASE 0
#define PROBE_DUP 0
#define RESID_LO 0
#define PG8_WGM 4
#include <hip/hip_runtime.h>
#include <cstdio>
#include <cstdint>

constexpr int D = 2048, BATCH = 2, SEQ = 8192, M = BATCH * SEQ, DEPTH = 4, DPLE = 256, DFF = 5504;
constexpr int MH = 4, DQK = 256, DV = 512, MPROJ = 2 * MH * DQK + 2 * MH * DV + 2 * MH;
constexpr int SBH = 16, SBD = 128;
constexpr float EPS = 1e-6f;

typedef float f32x16 __attribute__((ext_vector_type(16)));

__device__ __forceinline__ float wave_sum(float v) {
#pragma unroll
    for (int o = 1; o < 64; o <<= 1) v += __shfl_xor(v, o);
    return v;
}
__device__ __forceinline__ float sigmoidf_(float x) { return 1.0f / (1.0f + expf(-x)); }
__device__ __forceinline__ float logsigmoidf_(float x) { return fminf(x, 0.f) - log1pf(expf(-fabsf(x))); }

__global__ __launch_bounds__(256) void k_s_rmsnorm(const float* __restrict__ x, const float* __restrict__ g, float* __restrict__ y, int rows) {
    const int row = blockIdx.x * 4 + (threadIdx.x >> 6), lane = threadIdx.x & 63;
    if (row >= rows) return;
    const float4* xr = (const float4*)(x + (size_t)row * D);
    float4 v[8]; float s = 0.f;
#pragma unroll
    for (int j = 0; j < 8; ++j) { v[j] = xr[lane + 64 * j]; s += v[j].x * v[j].x + v[j].y * v[j].y + v[j].z * v[j].z + v[j].w * v[j].w; }
    s = wave_sum(s);
    const float r = 1.0f / sqrtf(s * (1.0f / D) + EPS);
    const float4* gr = (const float4*)g; float4* yr = (float4*)(y + (size_t)row * D);
#pragma unroll
    for (int j = 0; j < 8; ++j) { const float4 gg = gr[lane + 64 * j]; float4 o; o.x = v[j].x * r * gg.x; o.y = v[j].y * r * gg.y; o.z = v[j].z * r * gg.z; o.w = v[j].w * r * gg.w; yr[lane + 64 * j] = o; }
}

__global__ __launch_bounds__(256) void k_s_headnorm(float* x, int ld, int nheads, int hd, const float* __restrict__ g, int gstride, float scale,
                                                    const float* __restrict__ gate, int gate_ld, int rows) {
    const int w = blockIdx.x * 4 + (threadIdx.x >> 6), lane = threadIdx.x & 63;
    const int row = w / nheads, h = w % nheads;
    if (row >= rows) return;
    float* p = x + (size_t)row * ld + h * hd;
    float s = 0.f;
    for (int e = lane; e < hd; e += 64) { const float v = p[e]; s += v * v; }
    s = wave_sum(s);
    const float r = (1.0f / sqrtf(s / (float)hd + EPS)) * scale;
    for (int e = lane; e < hd; e += 64) {
        float v = p[e] * r * g[h * gstride + e];
        if (gate) v *= sigmoidf_(gate[(size_t)row * gate_ld + h * hd + e]);
        p[e] = v;
    }
}

__global__ __launch_bounds__(256) void k_s_gemm(const float* __restrict__ A, int lda, const float* __restrict__ W, int ldw, float* C, int ldc, int N, int K, float alpha, int accum) {
    __shared__ __attribute__((aligned(16))) float As[16][132];
    __shared__ __attribute__((aligned(16))) float Bs[16][132];
    const int tid = threadIdx.x, lane = tid & 63, wid = tid >> 6, wm = wid >> 1, wn = wid & 1;
    const int m0 = blockIdx.y * 128, n0 = blockIdx.x * 128;
    f32x16 acc[2][2];
#pragma unroll
    for (int i = 0; i < 2; ++i)
#pragma unroll
        for (int j = 0; j < 2; ++j)
#pragma unroll
            for (int r = 0; r < 16; ++r) acc[i][j][r] = 0.f;
    const int arow = tid >> 1, akseg = (tid & 1) * 8;
    const int bk = tid >> 4, bc = (tid & 15) * 8;
    const float* ap = A + (size_t)(m0 + arow) * lda + akseg;
    const float4 z4 = make_float4(0.f, 0.f, 0.f, 0.f);
    for (int k0 = 0; k0 < K; k0 += 16) {
        const float4 a0 = *(const float4*)(ap + k0), a1 = *(const float4*)(ap + k0 + 4);
        const float* wp = W + (size_t)(k0 + bk) * ldw + n0 + bc;
        float4 b0 = z4, b1 = z4;
        if (n0 + bc < N) b0 = *(const float4*)wp;
        if (n0 + bc + 4 < N) b1 = *(const float4*)(wp + 4);
        __syncthreads();
        As[akseg + 0][arow] = a0.x; As[akseg + 1][arow] = a0.y; As[akseg + 2][arow] = a0.z; As[akseg + 3][arow] = a0.w;
        As[akseg + 4][arow] = a1.x; As[akseg + 5][arow] = a1.y; As[akseg + 6][arow] = a1.z; As[akseg + 7][arow] = a1.w;
        *(float4*)&Bs[bk][bc] = b0; *(float4*)&Bs[bk][bc + 4] = b1;
        __syncthreads();
#pragma unroll
        for (int kk = 0; kk < 16; kk += 2) {
            float av[2], bv[2];
#pragma unroll
            for (int i = 0; i < 2; ++i) { av[i] = As[kk + (lane >> 5)][wm * 64 + i * 32 + (lane & 31)]; bv[i] = Bs[kk + (lane >> 5)][wn * 64 + i * 32 + (lane & 31)]; }
#pragma unroll
            for (int i = 0; i < 2; ++i)
#pragma unroll
                for (int j = 0; j < 2; ++j) acc[i][j] = __builtin_amdgcn_mfma_f32_32x32x2f32(av[i], bv[j], acc[i][j], 0, 0, 0);
        }
    }
#pragma unroll
    for (int i = 0; i < 2; ++i)
#pragma unroll
        for (int j = 0; j < 2; ++j)
#pragma unroll
            for (int r = 0; r < 16; ++r) {
                const int row = m0 + wm * 64 + i * 32 + (r & 3) + 8 * (r >> 2) + 4 * (lane >> 5), col = n0 + wn * 64 + j * 32 + (lane & 31);
                if (col < N) { float* p = C + (size_t)row * ldc + col; float v = alpha * acc[i][j][r]; if (accum) v += *p; *p = v; }
            }
}

__global__ void k_s_swiglu(float* __restrict__ G, const float* __restrict__ U, size_t n) {
    for (size_t i = (size_t)blockIdx.x * blockDim.x + threadIdx.x; i < n; i += (size_t)gridDim.x * blockDim.x) { const float g = G[i]; G[i] = g * sigmoidf_(g) * U[i]; }
}
__global__ void k_s_ple(float* __restrict__ h, const float* __restrict__ Pj, const float* __restrict__ Gt, size_t n) {
    for (size_t i = (size_t)blockIdx.x * blockDim.x + threadIdx.x; i < n; i += (size_t)gridDim.x * blockDim.x) h[i] += Pj[i] * sigmoidf_(Gt[i]);
}
__global__ void k_s_copy(float* __restrict__ dst, const float* __restrict__ src, size_t n4) {
    for (size_t i = (size_t)blockIdx.x * blockDim.x + threadIdx.x; i < n4; i += (size_t)gridDim.x * blockDim.x) ((float4*)dst)[i] = ((const float4*)src)[i];
}

__global__ __launch_bounds__(256) void k_s_mlstm(const float* __restrict__ proj, const float* __restrict__ b_if, float* __restrict__ hraw, int S) {
    const int w = blockIdx.x * 4 + (threadIdx.x >> 6), lane = threadIdx.x & 63;
    const int h = w / 128, cg = w % 128, c = lane & 3, dkg = lane >> 2, col = cg * 4 + c;
    const float bi = b_if[h], bf = b_if[MH + h];
    float Cst[16], nst[16];
#pragma unroll
    for (int i = 0; i < 16; ++i) { Cst[i] = 0.f; nst[i] = 0.f; }
    float m = 0.f;
    const float* pq = proj + h * DQK + dkg * 16; const float* pk = proj + MH * DQK + h * DQK + dkg * 16;
    const float* pv = proj + 2 * MH * DQK + h * DV + col; const float* pgi = proj + 2 * MH * DQK + 2 * MH * DV + h; const float* pgf = pgi + MH;
    float4 qn[4], kn[4]; float vn, gin, gfn;
#pragma unroll
    for (int i = 0; i < 4; ++i) { qn[i] = ((const float4*)pq)[i]; kn[i] = ((const float4*)pk)[i]; }
    vn = pv[0]; gin = pgi[0]; gfn = pgf[0];
    for (int t = 0; t < S; ++t) {
        float qf[16], kf[16];
#pragma unroll
        for (int i = 0; i < 4; ++i) { qf[4 * i] = qn[i].x; qf[4 * i + 1] = qn[i].y; qf[4 * i + 2] = qn[i].z; qf[4 * i + 3] = qn[i].w; kf[4 * i] = kn[i].x; kf[4 * i + 1] = kn[i].y; kf[4 * i + 2] = kn[i].z; kf[4 * i + 3] = kn[i].w; }
        const float v = vn, gi = gin, gf = gfn;
        if (t + 1 < S) { const size_t ro = (size_t)(t + 1) * MPROJ;
#pragma unroll
            for (int i = 0; i < 4; ++i) { qn[i] = ((const float4*)(pq + ro))[i]; kn[i] = ((const float4*)(pk + ro))[i]; }
            vn = pv[ro]; gin = pgi[ro]; gfn = pgf[ro]; }
        const float logi = gi + bi, logf = logsigmoidf_(gf + bf);
        const float mn = fmaxf(logf + m, logi);
        const float fd = expf(logf + m - mn), iw = expf(logi - mn);
        float num = 0.f, den = 0.f;
#pragma unroll
        for (int i = 0; i < 16; ++i) { const float kk = iw * kf[i]; Cst[i] = fd * Cst[i] + kk * v; nst[i] = fd * nst[i] + kk; num += qf[i] * Cst[i]; den += qf[i] * nst[i]; }
#pragma unroll
        for (int o = 4; o < 64; o <<= 1) { num += __shfl_xor(num, o); den += __shfl_xor(den, o); }
        num *= 0.0625f; den *= 0.0625f;
        const float hv = num / fmaxf(fabsf(den), expf(-mn));
        m = mn;
        if (dkg == 0) hraw[(size_t)t * (MH * DV) + h * DV + col] = hv;
    }
}

__global__ __launch_bounds__(256) void k_s_sbattn(const float* __restrict__ q, const float* __restrict__ kv, float* __restrict__ o, int S) {
    __shared__ float qs[4][4][SBD];
    const int wv = threadIdx.x >> 6, lane = threadIdx.x & 63;
    const int w = blockIdx.x * 4 + wv, h = w % SBH, t0 = (w / SBH) * 4;
#pragma unroll
    for (int i = 0; i < 8; ++i) { const int idx = lane + 64 * i, qi = idx >> 7, d = idx & 127; qs[wv][qi][d] = q[(size_t)(t0 + qi) * (SBH * SBD) + h * SBD + d]; }
    __syncthreads();
    float carry[4] = {0.f, 0.f, 0.f, 0.f}, oacc[4][2] = {{0.f, 0.f}, {0.f, 0.f}, {0.f, 0.f}, {0.f, 0.f}};
    for (int sb = t0 + 2; sb >= 0; sb -= 64) {
        const int s = sb - lane; const bool valid = s >= 0;
        float z[4] = {0.f, 0.f, 0.f, 0.f};
        if (valid) { const float4* kr = (const float4*)(kv + (size_t)s * (2 * SBH * SBD) + h * SBD);
            for (int d4 = 0; d4 < 32; ++d4) { const float4 kk = kr[d4];
#pragma unroll
                for (int qi = 0; qi < 4; ++qi) { const float* qq = &qs[wv][qi][4 * d4]; z[qi] += kk.x * qq[0] + kk.y * qq[1] + kk.z * qq[2] + kk.w * qq[3]; } } }
        float Aw[4];
#pragma unroll
        for (int qi = 0; qi < 4; ++qi) {
            const bool act = valid && s < t0 + qi;
            const float lb = logsigmoidf_(z[qi]); const float lk = act ? (lb - z[qi]) : 0.f;
            float incl = lk;
#pragma unroll
            for (int off = 1; off < 64; off <<= 1) { const float tv = __shfl_up(incl, off); if (lane >= off) incl += tv; }
            Aw[qi] = act ? expf(lb + carry[qi] + (incl - lk)) : 0.f;
            carry[qi] += __shfl(incl, 63);
        }
        const int nk = (sb + 1 < 64) ? sb + 1 : 64;
        for (int i = 0; i < nk; ++i) {
            const float2 vv = *(const float2*)(kv + (size_t)(sb - i) * (2 * SBH * SBD) + SBH * SBD + h * SBD + 2 * lane);
#pragma unroll
            for (int qi = 0; qi < 4; ++qi) { const float a = __shfl(Aw[qi], i); oacc[qi][0] += a * vv.x; oacc[qi][1] += a * vv.y; }
        }
    }
#pragma unroll
    for (int qi = 0; qi < 4; ++qi) *(float2*)(o + (size_t)(t0 + qi) * (SBH * SBD) + h * SBD + 2 * lane) = make_float2(oacc[qi][0], oacc[qi][1]);
}

struct Inputs {
    const float *x, *p, *ffn_norm, *ffn_wg, *ffn_wu, *ffn_wd, *mix_norm, *m_win, *m_bif, *m_hn, *m_wout, *kv_norm, *w_kv, *k_norm, *w_q, *q_norm, *w_o, *ple_norm, *ple_wp, *ple_wg;
};
static void s_gemm(hipStream_t st, const float* A, int lda, const float* W, int ldw, float* C, int ldc, int rows, int N, int K, float alpha, int accum) {
    dim3 grid((N + 127) / 128, rows / 128);
    hipLaunchKernelGGL(k_s_gemm, grid, dim3(256), 0, st, A, lda, W, ldw, C, ldc, N, K, alpha, accum);
}
constexpr size_t MiB = 1u << 20;
constexpr size_t S_HN_BYTES = (size_t)M * D * 4, S_T_BYTES = (size_t)SEQ * MPROJ * 4, S_KV_BYTES = (size_t)M * 4096 * 4;

static void s_ffn(hipStream_t st, const Inputs& in, int layer, int half, float* h, float* hn, float* T) {
    const size_t wi = (size_t)(layer * 2 + half);
    hipLaunchKernelGGL(k_s_rmsnorm, dim3(M / 4), dim3(256), 0, st, h, in.ffn_norm + wi * D, hn, M);
    const int R = 4096; float* G = T; float* U = T + (size_t)R * DFF;
    for (int r0 = 0; r0 < M; r0 += R) {
        s_gemm(st, hn + (size_t)r0 * D, D, in.ffn_wg + wi * D * DFF, DFF, G, DFF, R, DFF, D, 1.f, 0);
        s_gemm(st, hn + (size_t)r0 * D, D, in.ffn_wu + wi * D * DFF, DFF, U, DFF, R, DFF, D, 1.f, 0);
        hipLaunchKernelGGL(k_s_swiglu, dim3(2048), dim3(256), 0, st, G, U, (size_t)R * DFF);
        s_gemm(st, G, DFF, in.ffn_wd + wi * DFF * D, D, h + (size_t)r0 * D, D, R, D, DFF, 0.5f, 1);
    }
}
static void s_mlstm(hipStream_t st, const Inputs& in, int layer, float* h, float* hn, float* T) {
    hipLaunchKernelGGL(k_s_rmsnorm, dim3(M / 4), dim3(256), 0, st, h, in.mix_norm + (size_t)layer * D, hn, M);
    float* proj = T;
    for (int b = 0; b < BATCH; ++b) {
        float* hraw = hn + (size_t)b * SEQ * D;
        s_gemm(st, hn + (size_t)b * SEQ * D, D, in.m_win + (size_t)layer * D * MPROJ, MPROJ, proj, MPROJ, SEQ, MPROJ, D, 1.f, 0);
        hipLaunchKernelGGL(k_s_mlstm, dim3(MH * 128 / 4), dim3(256), 0, st, proj, in.m_bif + layer * 2 * MH, hraw, SEQ);
        hipLaunchKernelGGL(k_s_headnorm, dim3(SEQ * MH / 4), dim3(256), 0, st, hraw, MH * DV, MH, DV, in.m_hn + (size_t)layer * MH * DV, DV, 1.0f, proj + 2 * MH * DQK + MH * DV, MPROJ, SEQ);
        s_gemm(st, hraw, MH * DV, in.m_wout + (size_t)layer * MH * DV * D, D, h + (size_t)b * SEQ * D, D, SEQ, D, MH * DV, 1.f, 1);
    }
}
static void s_kv(hipStream_t st, const Inputs& in, float* h, float* hn, float* KV) {
    hipLaunchKernelGGL(k_s_rmsnorm, dim3(M / 4), dim3(256), 0, st, h, in.kv_norm, hn, M);
    s_gemm(st, hn, D, in.w_kv, 2 * SBH * SBD, KV, 2 * SBH * SBD, M, 2 * SBH * SBD, D, 1.f, 0);
    hipLaunchKernelGGL(k_s_headnorm, dim3(M * SBH / 4), dim3(256), 0, st, KV, 2 * SBH * SBD, SBH, SBD, in.k_norm, 0, 1.0f, (const float*)nullptr, 0, M);
}
static void s_sb(hipStream_t st, const Inputs& in, int j, int layer, float* h, float* hn, float* T, float* KV) {
    hipLaunchKernelGGL(k_s_rmsnorm, dim3(M / 4), dim3(256), 0, st, h, in.mix_norm + (size_t)layer * D, hn, M);
    float* q = T; float* o = T + (size_t)SEQ * D;
    for (int b = 0; b < BATCH; ++b) {
        s_gemm(st, hn + (size_t)b * SEQ * D, D, in.w_q + (size_t)j * D * D, D, q, D, SEQ, D, D, 1.f, 0);
        hipLaunchKernelGGL(k_s_headnorm, dim3(SEQ * SBH / 4), dim3(256), 0, st, q, SBH * SBD, SBH, SBD, in.q_norm + j * SBD, 0, 0.08838834764831845f, (const float*)nullptr, 0, SEQ);
        hipLaunchKernelGGL(k_s_sbattn, dim3(SBH * (SEQ / 4) / 4), dim3(256), 0, st, q, KV + (size_t)b * SEQ * 4096, o, SEQ);
        s_gemm(st, o, D, in.w_o + (size_t)j * D * D, D, h + (size_t)b * SEQ * D, D, SEQ, D, D, 1.f, 1);
    }
}
static void s_ple(hipStream_t st, const Inputs& in, int layer, float* h, float* hn, float* T) {
    hipLaunchKernelGGL(k_s_rmsnorm, dim3(M / 4), dim3(256), 0, st, h, in.ple_norm + (size_t)layer * D, hn, M);
    const int R = 8192; float* Gt = T; float* Pj = T + (size_t)R * D;
    for (int r0 = 0; r0 < M; r0 += R) {
        s_gemm(st, hn + (size_t)r0 * D, D, in.ple_wg + (size_t)layer * D * D, D, Gt, D, R, D, D, 1.f, 0);
        s_gemm(st, in.p + ((size_t)layer * M + r0) * DPLE, DPLE, in.ple_wp + (size_t)layer * DPLE * D, D, Pj, D, R, D, DPLE, 1.f, 0);
        hipLaunchKernelGGL(k_s_ple, dim3(2048), dim3(256), 0, st, h + (size_t)r0 * D, Pj, Gt, (size_t)R * D);
    }
}

#ifndef PG8_WGM
#define PG8_WGM 8
#endif
namespace pg8 {
#define PG8_LAS __attribute__((address_space(3)))
typedef unsigned short bf16_t;
typedef short bf16x8 __attribute__((ext_vector_type(8)));
typedef float f32x4 __attribute__((ext_vector_type(4)));
typedef unsigned u32x4 __attribute__((ext_vector_type(4)));
constexpr int BM = 256, BK = 64, HALF = 128, HTB = HALF * BK * 2  , STAGE_BYTES = 8 * HTB, NXCD = 8, WGM = PG8_WGM;

__host__ __device__ __forceinline__ int lds_byte(int r, int c) { const int st = (r >> 4) * 2 + (c >> 5), rr = r & 15, cc = c & 31, ob = rr * 64 + cc * 2; return st * 1024 + (ob ^ (((ob >> 9) & 1) << 5)); }
__host__ __device__ __forceinline__ void stage_rc(int b, int& R, int& C) { const int st = b / 1024, sb = b % 1024, swz = sb ^ (((sb >> 9) & 1) << 5); R = (st >> 1) * 16 + swz / 64; C = (st & 1) * 32 + (swz % 64) / 2; }
__host__ __device__ __forceinline__ int perm32(int rho) { const int n = rho >> 4, i = rho & 15; return 8 * (i >> 2) + 4 * n + (i & 3); }

struct Unit { int pm, pn; };
struct Gemm { const bf16_t* A; const bf16_t* Bt; int M, N, K; };

struct StaticOrder {
    int nM, nN, nwg, G, c, wgm;
    __host__ __device__ void init(int M, int N, int G_, int c_, int wgm_ = WGM) { nM = M / BM; nN = N / BM; nwg = nM * nN; G = G_; c = c_; wgm = wgm_; }
    __host__ __device__ bool next(int i, Unit& u) const {
        const long L = (long)i * G + c; if (L >= nwg) return false;
        int wgid = (int)L; { const int q = nwg / NXCD, r = nwg % NXCD, xcd = wgid % NXCD, off = wgid / NXCD; wgid = (xcd < r ? xcd * (q + 1) : r * (q + 1) + (xcd - r) * q) + off; }
        const int nig = wgm * nN, gid = wgid / nig, fm = gid * wgm, gsz = (nM - fm) < wgm ? (nM - fm) : wgm;
        u.pm = fm + ((wgid % nig) % gsz); u.pn = (wgid % nig) / gsz; return true;
    }
    __device__ __forceinline__ void a_ready(const Unit&) const {}
    __device__ __forceinline__ void done(const Unit&) const {}
};


template <class Epi, class Sched, bool ALIGN_EPI = false, bool SP2 = false>
__device__ __forceinline__ void gemm_phase(PG8_LAS unsigned char* lds, const Gemm g, const Sched& S, const Epi& E, const int tid) {
    const int wid = __builtin_amdgcn_readfirstlane(tid >> 6), lane = tid & 63, wr = wid >> 2, wc = wid & 3, fr = lane & 15, fq = lane >> 4;
    const int K = g.K, nt = K / BK;
    unsigned voffA[2], voffB[2];
#pragma unroll
    for (int i = 0; i < 2; ++i) { int R, C; stage_rc(tid * 16 + i * 8192, R, C); const int Rb = Epi::PERM ? ((R & ~31) + perm32(R & 31)) : R;
        voffA[i] = (unsigned)(R * K + C) * 2u; voffB[i] = (unsigned)(Rb * K + C) * 2u; }
    const size_t kstep = (size_t)(BK * 2);
    const size_t hstep = (size_t)HALF * K * 2;
    const size_t tstep = 2 * hstep;
    const unsigned ldsw = (unsigned)wid * 1024u;
    const int aoff = lds_byte(wr * 64 + fr, fq * 8), boff = lds_byte(wc * 32 + fr, fq * 8);
#define PG8_SA(b, h) (((b) * 2 + (h)) * HTB)
#define PG8_SB(b, h) ((4 + (b) * 2 + (h)) * HTB)
#define PG8_STAGE(bufoff, gbase, voff) do { _Pragma("unroll") for (int _i = 0; _i < 2; ++_i) \
        __builtin_amdgcn_global_load_lds((const unsigned*)((const char*)(gbase) + (voff)[_i]), (PG8_LAS unsigned*)(lds + (bufoff) + ldsw + _i * 8192), 16, 0, 0); } while (0)
#define PG8_LDA(dst, b, h) do { _Pragma("unroll") for (int m = 0; m < 4; ++m) _Pragma("unroll") for (int k = 0; k < 2; ++k) dst[m][k] = *(const PG8_LAS bf16x8*)(lds + PG8_SA(b, h) + aoff + m * 2048 + k * 1024); } while (0)
#define PG8_LDB(dst, b, h) do { _Pragma("unroll") for (int n = 0; n < 2; ++n) _Pragma("unroll") for (int k = 0; k < 2; ++k) dst[n][k] = *(const PG8_LAS bf16x8*)(lds + PG8_SB(b, h) + boff + n * 2048 + k * 1024); } while (0)
#define PG8_MMA(ai, bj, At, Bt) do { __builtin_amdgcn_s_setprio(1); _Pragma("unroll") for (int m = 0; m < 4; ++m) _Pragma("unroll") for (int n = 0; n < 2; ++n) _Pragma("unroll") for (int k = 0; k < 2; ++k) \
        acc[ai][bj][m][n] = __builtin_amdgcn_mfma_f32_16x16x32_bf16(Bt[n][k], At[m][k], acc[ai][bj][m][n], 0, 0, 0); __builtin_amdgcn_s_setprio(0); } while (0)
#define PG8_WAIT_V(n) asm volatile("s_waitcnt vmcnt(" #n ")" ::: "memory")
#define PG8_WAIT_L(n) asm volatile("s_waitcnt lgkmcnt(" #n ")" ::: "memory")
#define PG8_BAR __builtin_amdgcn_s_barrier()
#define PG8_SCHED __builtin_amdgcn_sched_barrier(0)
    Unit cur, nxt; int ui = 0;
    if (!S.next(0, cur)) return;
    f32x4 acc[2][2][4][2];
#pragma unroll
    for (int a = 0; a < 2; ++a)
#pragma unroll
        for (int b = 0; b < 2; ++b)
#pragma unroll
            for (int m = 0; m < 4; ++m)
#pragma unroll
                for (int n = 0; n < 2; ++n) acc[a][b][m][n] = (f32x4){0.f, 0.f, 0.f, 0.f};
    bf16x8 At[4][2], B0[2][2], B1[2][2];
    const char* cA = (const char*)g.A + (size_t)cur.pm * tstep; const char* cB = (const char*)g.Bt + (size_t)cur.pn * tstep;
    E.prep_all(S, tid);
    if constexpr (SP2) {
        PG8_STAGE(PG8_SB(0, 0), cB, voffB); PG8_STAGE(PG8_SB(0, 1), cB + hstep, voffB); PG8_STAGE(PG8_SA(0, 0), cA, voffA); PG8_STAGE(PG8_SA(0, 1), cA + hstep, voffA);
        if (wr == 1) PG8_BAR;
        PG8_WAIT_V(2); PG8_BAR;
        PG8_STAGE(PG8_SB(1, 0), cB + kstep, voffB); PG8_STAGE(PG8_SA(1, 0), cA + kstep, voffA); PG8_STAGE(PG8_SB(1, 1), cB + hstep + kstep, voffB);
        PG8_WAIT_V(6); PG8_BAR;
    } else {
        PG8_STAGE(PG8_SB(0, 0), cB, voffB); PG8_STAGE(PG8_SA(0, 0), cA, voffA); PG8_STAGE(PG8_SB(0, 1), cB + hstep, voffB); PG8_STAGE(PG8_SA(0, 1), cA + hstep, voffA);
        if (wr == 1) PG8_BAR;
        PG8_WAIT_V(4); PG8_BAR;
        PG8_STAGE(PG8_SB(1, 0), cB + kstep, voffB); PG8_STAGE(PG8_SA(1, 0), cA + kstep, voffA); PG8_STAGE(PG8_SB(1, 1), cB + hstep + kstep, voffB);
        PG8_WAIT_V(6); PG8_BAR;
    }
    for (;;) {
        const bool has_next = S.next(ui + 1, nxt);
        const char* nA = has_next ? (const char*)g.A + (size_t)nxt.pm * tstep : cA; const char* nB = has_next ? (const char*)g.Bt + (size_t)nxt.pn * tstep : cB;
        for (int t = 0; t < nt; t += 2) {
            const bool last = (t == nt - 2);
            const char* a1 = cA + (size_t)(t + 1) * kstep;
            const char* a2 = last ? nA : cA + (size_t)(t + 2) * kstep; const char* b2 = last ? nB : cB + (size_t)(t + 2) * kstep;
            const char* a3 = a2 + kstep; const char* b3 = b2 + kstep;
            if constexpr (SP2) {
            PG8_LDB(B0, 0, 0); PG8_LDB(B1, 0, 1); PG8_SCHED; PG8_LDA(At, 0, 0); PG8_STAGE(PG8_SA(1, 1), a1 + hstep, voffA);
            PG8_WAIT_V(8); PG8_WAIT_L(0); PG8_BAR; PG8_MMA(0, 0, At, B0); PG8_MMA(0, 1, At, B1); PG8_BAR; PG8_SCHED;
            PG8_LDA(At, 0, 1); PG8_STAGE(PG8_SB(0, 0), b2, voffB); PG8_STAGE(PG8_SB(0, 1), b2 + hstep, voffB); PG8_STAGE(PG8_SA(0, 0), a2, voffA);
            PG8_WAIT_V(8); PG8_WAIT_L(0); PG8_BAR; PG8_MMA(1, 0, At, B0); PG8_MMA(1, 1, At, B1); PG8_BAR; PG8_SCHED;
            PG8_LDB(B0, 1, 0); PG8_LDB(B1, 1, 1); PG8_SCHED; PG8_LDA(At, 1, 0); PG8_STAGE(PG8_SA(0, 1), a2 + hstep, voffA);
            PG8_WAIT_V(8); PG8_WAIT_L(0); PG8_BAR; PG8_MMA(0, 0, At, B0); PG8_MMA(0, 1, At, B1); PG8_BAR; PG8_SCHED;
            PG8_LDA(At, 1, 1); PG8_STAGE(PG8_SB(1, 0), b3, voffB); PG8_STAGE(PG8_SB(1, 1), b3 + hstep, voffB); PG8_STAGE(PG8_SA(1, 0), a3, voffA);
            PG8_WAIT_V(8); PG8_WAIT_L(0); PG8_BAR; PG8_MMA(1, 0, At, B0); PG8_MMA(1, 1, At, B1); PG8_BAR; PG8_SCHED;
            } else {
            PG8_LDB(B0, 0, 0); PG8_SCHED; PG8_LDA(At, 0, 0); PG8_STAGE(PG8_SA(1, 1), a1 + hstep, voffA);
            PG8_WAIT_L(8); PG8_BAR; PG8_WAIT_L(0); PG8_MMA(0, 0, At, B0); PG8_BAR; PG8_SCHED;
            PG8_LDB(B1, 0, 1); PG8_STAGE(PG8_SB(0, 0), b2, voffB);
            PG8_BAR; PG8_WAIT_L(0); PG8_MMA(0, 1, At, B1); PG8_BAR;
            PG8_LDA(At, 0, 1); PG8_STAGE(PG8_SA(0, 0), a2, voffA);
            PG8_BAR; PG8_WAIT_L(0); PG8_MMA(1, 0, At, B0); PG8_BAR; PG8_SCHED;
            PG8_STAGE(PG8_SB(0, 1), b2 + hstep, voffB);
            PG8_WAIT_V(6); PG8_BAR; PG8_MMA(1, 1, At, B1); PG8_BAR;
            PG8_LDB(B0, 1, 0); PG8_SCHED; PG8_LDA(At, 1, 0); PG8_STAGE(PG8_SA(0, 1), a2 + hstep, voffA);
            PG8_WAIT_L(8); PG8_BAR; PG8_WAIT_L(0); PG8_MMA(0, 0, At, B0); PG8_BAR; PG8_SCHED;
            PG8_LDB(B1, 1, 1); PG8_STAGE(PG8_SB(1, 0), b3, voffB);
            PG8_BAR; PG8_WAIT_L(0); PG8_MMA(0, 1, At, B1); PG8_BAR;
            PG8_LDA(At, 1, 1); PG8_STAGE(PG8_SA(1, 0), a3, voffA);
            PG8_BAR; PG8_WAIT_L(0); PG8_MMA(1, 0, At, B0); PG8_BAR; PG8_SCHED;
            PG8_STAGE(PG8_SB(1, 1), b3 + hstep, voffB);
            PG8_WAIT_V(6); PG8_BAR; PG8_MMA(1, 1, At, B1); PG8_BAR;
            }
        }
        if constexpr (ALIGN_EPI) { if (wr == 0) PG8_BAR; }
        E(acc, cur, ui, wr, wc, fr, fq);
        if (!has_next) break;
#pragma unroll
        for (int a = 0; a < 2; ++a)
#pragma unroll
            for (int b = 0; b < 2; ++b)
#pragma unroll
                for (int m = 0; m < 4; ++m)
#pragma unroll
                    for (int n = 0; n < 2; ++n) acc[a][b][m][n] = (f32x4){0.f, 0.f, 0.f, 0.f};
        cur = nxt; cA = nA; cB = nB; ++ui;
        if constexpr (ALIGN_EPI) { if (wr == 1) PG8_BAR; }
    }
    PG8_WAIT_V(0);
    if constexpr (!ALIGN_EPI) { if (wr == 0) PG8_BAR; }
    PG8_BAR;
#undef PG8_SA
#undef PG8_SB
#undef PG8_STAGE
#undef PG8_LDA
#undef PG8_LDB
#undef PG8_MMA
#undef PG8_WAIT_V
#undef PG8_WAIT_L
#undef PG8_BAR
#undef PG8_SCHED
}
}

#define GAS __attribute__((address_space(1)))
#define LAS __attribute__((address_space(3)))
typedef unsigned short bf16;
typedef unsigned u32x4 __attribute__((ext_vector_type(4)));
typedef unsigned u32x2 __attribute__((ext_vector_type(2)));
typedef float f32x4 __attribute__((ext_vector_type(4)));
typedef float f32x2_t __attribute__((ext_vector_type(2)));
typedef __bf16 bf16x2_t __attribute__((ext_vector_type(2)));
typedef short bf16x8 __attribute__((ext_vector_type(8)));
typedef short s16x4 __attribute__((ext_vector_type(4)));
typedef GAS unsigned gu32;
#define RLX_AGENT __ATOMIC_RELAXED, __HIP_MEMORY_SCOPE_AGENT
#define LDS_WAIT() asm volatile("s_waitcnt lgkmcnt(0)" ::: "memory")
#define VM_WAIT() asm volatile("s_waitcnt vmcnt(0)" ::: "memory")

__device__ __forceinline__ unsigned cvtpk(float lo, float hi) { f32x2_t v = {lo, hi}; bf16x2_t b = __builtin_convertvector(v, bf16x2_t); return __builtin_bit_cast(unsigned, b); }
__device__ __forceinline__ float bf_lo(unsigned w) { return __uint_as_float(w << 16); }
__device__ __forceinline__ float bf_hi(unsigned w) { return __uint_as_float(w & 0xffff0000u); }
__device__ __forceinline__ float fast_sigmoid(float x) { return __builtin_amdgcn_rcpf(1.0f + __expf(-x)); }
constexpr int NWAVES = 8;
constexpr int TAB_UNITS = 12;
constexpr int RING_BYTES = 131072, TAB_OFF = RING_BYTES, HNB_OFF = TAB_OFF + TAB_UNITS * 1024, MISC_OFF = HNB_OFF + 8192, LDS_BYTES = MISC_OFF + 512;
static_assert(MISC_OFF + 256 <= LDS_BYTES, "LDS map");

struct RstdTab {
    const float* ss; LAS float* tab; int by_col;
    template <class Sched> __device__ __forceinline__ void prep_all(const Sched& S, int tid) const {
        if (ss == nullptr) return;
#pragma unroll 1
        for (int i0 = 0; i0 < TAB_UNITS; i0 += 2) {
            pg8::Unit u; const int i = i0 + (tid >> 8);
            if (S.next(i, u)) {
                const int idx = (by_col ? u.pn : u.pm) * 256 + (tid & 255);
                const f32x4* p = (const f32x4*)(ss + (size_t)idx * 32);
                f32x4 a = p[0];
#pragma unroll
                for (int k = 1; k < 8; ++k) a += p[k];
                const float s = (a[0] + a[1]) + (a[2] + a[3]);
                tab[i * 256 + (tid & 255)] = 1.0f / sqrtf(s * (1.0f / D) + EPS);
            }
            pg8::Unit u2; if (!S.next(i0 + 2, u2)) break;
        }
    }
};

struct EpiGU {
    static constexpr bool PERM = true;
    RstdTab rt; bf16* H;
    template <class Sched> __device__ __forceinline__ void prep_all(const Sched& S, int tid) const { rt.prep_all(S, tid); }
    __device__ __forceinline__ void operator()(const f32x4 (&acc)[2][2][4][2], const pg8::Unit& u, int ui, int wr, int wc, int fr_, int fq_) const {
        int fr = fr_, fq = fq_; asm volatile("" : "+v"(fr), "+v"(fq));
        const LAS float* tb = rt.tab + ui * 256;
        const int col0 = u.pn * 128 + wc * 32 + 8 * fq;
#pragma unroll
        for (int ai = 0; ai < 2; ++ai)
#pragma unroll
            for (int m = 0; m < 4; ++m) {
                const int r = ai * 128 + wr * 64 + m * 16 + fr; const float rs = tb[r], nrs = rs * -1.4426950408889634f, rs2 = rs * rs;
                float o[8];
#pragma unroll
                for (int n = 0; n < 2; ++n)
#pragma unroll
                    for (int e = 0; e < 4; ++e) { const float ag = acc[ai][0][m][n][e], au = acc[ai][1][m][n][e]; o[4 * n + e] = (ag * au) * rs2 * __builtin_amdgcn_rcpf(1.0f + __builtin_amdgcn_exp2f(ag * nrs)); }
                u32x4 w; w.x = cvtpk(o[0], o[1]); w.y = cvtpk(o[2], o[3]); w.z = cvtpk(o[4], o[5]); w.w = cvtpk(o[6], o[7]);
                *(u32x4*)(H + (size_t)(u.pm * 256 + r) * DFF + col0) = w;
            }
    }
};

#ifndef RESID_LO
#define RESID_LO 1
#endif
struct EpiRes {
    static constexpr bool PERM = true;
    RstdTab rt; const bf16* hin; bf16* lo; bf16* hb; float* sso; float* out; float alpha; const bf16* pj; int mode; int final;
    template <class Sched> __device__ __forceinline__ void prep_all(const Sched& S, int tid) const { rt.prep_all(S, tid); }
    __device__ __forceinline__ void operator()(const f32x4 (&acc)[2][2][4][2], const pg8::Unit& u, int ui, int wr, int wc, int fr_, int fq_) const {
        int fr = fr_, fq = fq_; asm volatile("" : "+v"(fr), "+v"(fq));
        const LAS float* tb = rt.tab + ui * 256;
        const int col0 = u.pn * 256 + wc * 32 + 8 * fq;
#pragma unroll
        for (int ai = 0; ai < 2; ++ai)
#pragma unroll
            for (int mb = 0; mb < 2; ++mb) {
                u32x4 hv[2][2], lv[2][2], pv[2][2];
#pragma unroll
                for (int mm = 0; mm < 2; ++mm)
#pragma unroll
                    for (int bj = 0; bj < 2; ++bj) {
                        const size_t off = (size_t)(u.pm * 256 + ai * 128 + wr * 64 + (2 * mb + mm) * 16 + fr) * D + col0 + bj * 128;
                        hv[mm][bj] = *(const u32x4*)(hin + off); lv[mm][bj] = RESID_LO ? *(const u32x4*)(lo + off) : (u32x4){0u, 0u, 0u, 0u};
                        if (mode == 1) pv[mm][bj] = *(const u32x4*)(pj + off);
                    }
                asm volatile("" ::: "memory");
#pragma unroll
                for (int mm = 0; mm < 2; ++mm) {
                    const int m = 2 * mb + mm, r = ai * 128 + wr * 64 + m * 16 + fr; const size_t row = (size_t)(u.pm * 256 + r);
                    float ssq = 0.f;
                    float rs = 1.f; if (mode == 1) rs = tb[r];
#pragma unroll
                    for (int bj = 0; bj < 2; ++bj) {
                        const size_t off = row * D + col0 + bj * 128;
                        const u32x4 hw = hv[mm][bj], lw = lv[mm][bj];
                        float o[8] = {bf_lo(hw.x) + bf_lo(lw.x), bf_hi(hw.x) + bf_hi(lw.x), bf_lo(hw.y) + bf_lo(lw.y), bf_hi(hw.y) + bf_hi(lw.y), bf_lo(hw.z) + bf_lo(lw.z), bf_hi(hw.z) + bf_hi(lw.z), bf_lo(hw.w) + bf_lo(lw.w), bf_hi(hw.w) + bf_hi(lw.w)};
                        if (mode == 0) {
#pragma unroll
                            for (int e = 0; e < 4; ++e) { o[e] += acc[ai][bj][m][0][e] * alpha; o[4 + e] += acc[ai][bj][m][1][e] * alpha; }
                        } else {
                            const u32x4 pw = pv[mm][bj];
                            const float pf[8] = {bf_lo(pw.x), bf_hi(pw.x), bf_lo(pw.y), bf_hi(pw.y), bf_lo(pw.z), bf_hi(pw.z), bf_lo(pw.w), bf_hi(pw.w)};
#pragma unroll
                            for (int e = 0; e < 4; ++e) { o[e] += pf[e] * fast_sigmoid(acc[ai][bj][m][0][e] * rs); o[4 + e] += pf[4 + e] * fast_sigmoid(acc[ai][bj][m][1][e] * rs); }
                        }
                        if (final) { *(f32x4*)(out + off) = (f32x4){o[0], o[1], o[2], o[3]}; *(f32x4*)(out + off + 4) = (f32x4){o[4], o[5], o[6], o[7]}; }
                        else {
                            u32x4 w; w.x = cvtpk(o[0], o[1]); w.y = cvtpk(o[2], o[3]); w.z = cvtpk(o[4], o[5]); w.w = cvtpk(o[6], o[7]);
                            u32x4 l; l.x = cvtpk(o[0] - bf_lo(w.x), o[1] - bf_hi(w.x)); l.y = cvtpk(o[2] - bf_lo(w.y), o[3] - bf_hi(w.y)); l.z = cvtpk(o[4] - bf_lo(w.z), o[5] - bf_hi(w.z)); l.w = cvtpk(o[6] - bf_lo(w.w), o[7] - bf_hi(w.w));
                            *(u32x4*)(hb + off) = w; if (RESID_LO) *(u32x4*)(lo + off) = l;
                            ssq += (o[0] * o[0] + o[1] * o[1]) + (o[2] * o[2] + o[3] * o[3]) + (o[4] * o[4] + o[5] * o[5]) + (o[6] * o[6] + o[7] * o[7]);
                        }
                    }
                    if (!final) { ssq += __shfl_xor(ssq, 16); ssq += __shfl_xor(ssq, 32); if (fq == 0) sso[row * 32 + u.pn * 4 + wc] = ssq; }
                }
            }
    }
};

struct EpiTok {
    static constexpr bool PERM = true;
    RstdTab rt; bf16* O; int ldo; const float* gain; LAS float* hnb; int hn;
    template <class Sched> __device__ __forceinline__ void prep_all(const Sched& S, int tid) const { rt.prep_all(S, tid); }
    __device__ __forceinline__ void operator()(const f32x4 (&acc)[2][2][4][2], const pg8::Unit& u, int ui, int wr, int wc, int fr_, int fq_) const {
        int fr = fr_, fq = fq_; asm volatile("" : "+v"(fr), "+v"(fq));
        const LAS float* tb = rt.tab + ui * 256;
        const int col0 = u.pn * 256 + wc * 32 + 8 * fq;
        float rs[2][4];
#pragma unroll
        for (int ai = 0; ai < 2; ++ai)
#pragma unroll
            for (int m = 0; m < 4; ++m) rs[ai][m] = (rt.ss != nullptr) ? tb[ai * 128 + wr * 64 + m * 16 + fr] : 1.0f;
        f32x4 g0 = {1.f, 1.f, 1.f, 1.f}, g1 = {1.f, 1.f, 1.f, 1.f};
        if (hn) {
            g0 = *(const f32x4*)(gain + wc * 32 + 8 * fq); g1 = *(const f32x4*)(gain + wc * 32 + 8 * fq + 4);
#pragma unroll
            for (int ai = 0; ai < 2; ++ai)
#pragma unroll
                for (int m = 0; m < 4; ++m)
#pragma unroll
                    for (int bj = 0; bj < 2; ++bj) {
                        const f32x4 v0 = acc[ai][bj][m][0] * rs[ai][m], v1 = acc[ai][bj][m][1] * rs[ai][m];
                        float q = (v0[0] * v0[0] + v0[1] * v0[1]) + (v0[2] * v0[2] + v0[3] * v0[3]) + (v1[0] * v1[0] + v1[1] * v1[1]) + (v1[2] * v1[2] + v1[3] * v1[3]);
                        q += __shfl_xor(q, 16); q += __shfl_xor(q, 32);
                        if (fq == 0) hnb[((wr * 128 + ai * 64 + m * 16 + fr) * 2 + bj) * 4 + wc] = q;
                    }
            asm volatile("s_waitcnt lgkmcnt(0)" ::: "memory"); __builtin_amdgcn_s_barrier(); asm volatile("" ::: "memory");
        }
#pragma unroll
        for (int ai = 0; ai < 2; ++ai)
#pragma unroll
            for (int m = 0; m < 4; ++m) {
                const int r = ai * 128 + wr * 64 + m * 16 + fr;
#pragma unroll
                for (int bj = 0; bj < 2; ++bj) {
                    float sc = rs[ai][m];
                    if (hn) { const f32x4 p = *(const LAS f32x4*)(hnb + ((wr * 128 + ai * 64 + m * 16 + fr) * 2 + bj) * 4); sc *= 1.0f / sqrtf(((p[0] + p[1]) + (p[2] + p[3])) * (1.0f / 128.0f) + EPS); }
                    const f32x4 v0 = acc[ai][bj][m][0] * sc * g0, v1 = acc[ai][bj][m][1] * sc * g1;
                    u32x4 w; w.x = cvtpk(v0[0], v0[1]); w.y = cvtpk(v0[2], v0[3]); w.z = cvtpk(v1[0], v1[1]); w.w = cvtpk(v1[2], v1[3]);
                    *(u32x4*)(O + (size_t)(u.pm * 256 + r) * ldo + col0 + bj * 128) = w;
                }
            }
    }
};

struct EpiTr {
    static constexpr bool PERM = true;
    RstdTab rt; bf16* O; int ldo;
    template <class Sched> __device__ __forceinline__ void prep_all(const Sched& S, int tid) const { rt.prep_all(S, tid); }
    __device__ __forceinline__ void operator()(const f32x4 (&acc)[2][2][4][2], const pg8::Unit& u, int ui, int wr, int wc, int fr_, int fq_) const {
        int fr = fr_, fq = fq_; asm volatile("" : "+v"(fr), "+v"(fq));
        const LAS float* tb = rt.tab + ui * 256;
        const int cb = wc * 32 + 8 * fq;
        f32x4 rc[2][2];
#pragma unroll
        for (int bj = 0; bj < 2; ++bj)
#pragma unroll
            for (int n = 0; n < 2; ++n) rc[bj][n] = *(const LAS f32x4*)(tb + bj * 128 + cb + 4 * n);
#pragma unroll
        for (int ai = 0; ai < 2; ++ai)
#pragma unroll
            for (int m = 0; m < 4; ++m) {
                const size_t row = (size_t)(u.pm * 256 + ai * 128 + wr * 64 + m * 16 + fr);
#pragma unroll
                for (int bj = 0; bj < 2; ++bj) {
                    const f32x4 v0 = acc[ai][bj][m][0] * rc[bj][0], v1 = acc[ai][bj][m][1] * rc[bj][1];
                    u32x4 w; w.x = cvtpk(v0[0], v0[1]); w.y = cvtpk(v0[2], v0[3]); w.z = cvtpk(v1[0], v1[1]); w.w = cvtpk(v1[2], v1[3]);
                    *(u32x4*)(O + row * ldo + u.pn * 256 + bj * 128 + cb) = w;
                }
            }
    }
};


#define XB_TMO      128
#define XB_XCNT(j)  (256  + 64 * (j))
#define XB_XSUB(j)  (1280 + 64 * (j))
#define XB_XGEN(j)  (2304 + 64 * (j))
#define XB_TOP      3328
#define XB_TOPGEN   3392
#define XCD_BAR_WORDS 3456
#define XB_SPIN_CAP (1u << 18)

__device__ __forceinline__ unsigned xb_ld(unsigned* p)              { return __hip_atomic_load(p, __ATOMIC_RELAXED, __HIP_MEMORY_SCOPE_AGENT); }
__device__ __forceinline__ unsigned xb_add(unsigned* p, unsigned v) { return __hip_atomic_fetch_add(p, v, __ATOMIC_RELAXED, __HIP_MEMORY_SCOPE_AGENT); }
__device__ __forceinline__ unsigned xb_xcc_id() { return (unsigned)__builtin_amdgcn_s_getreg((3 << 11) | 20) & 0xFu; }
#define XB_SPIN(cond, bar) do { unsigned _sp = 0; while (cond) { __builtin_amdgcn_s_sleep(1); \
    if ((++_sp & 255u) == 0u) { if (xb_ld(&(bar)[XB_TMO])) break; if (_sp > XB_SPIN_CAP) { atomicAdd(&(bar)[XB_TMO], 1u); break; } } } } while (0)

struct XcdBarrier { unsigned* bar; unsigned x; volatile LAS unsigned* st; };
__device__ __forceinline__ XcdBarrier xcd_barrier_post(unsigned* bar, volatile LAS unsigned* st, int tid) {
    XcdBarrier b; b.bar = bar; b.x = xb_xcc_id(); b.st = st;
    if (tid == 0) (void)xb_add(&bar[XB_XCNT(b.x)], 1u);
    return b;
}
__device__ __forceinline__ void xcd_barrier_complete(unsigned* bar, unsigned x, unsigned& nloc, unsigned& nx) {
    const unsigned G = gridDim.x * gridDim.y * gridDim.z;
    unsigned sum, cnt, mine, sp = 0u;
    for (;;) {
        sum = 0u; cnt = 0u; mine = 0u;
#pragma unroll
        for (unsigned j = 0; j < 16; ++j) { const unsigned c = xb_ld(&bar[XB_XCNT(j)]); sum += c; cnt += (c > 0u) ? 1u : 0u; mine = (j == x) ? c : mine; }
        if (sum == G) break;
        __builtin_amdgcn_s_sleep(1);
        if ((++sp & 255u) == 0u) { if (xb_ld(&bar[XB_TMO])) break; if (sp > XB_SPIN_CAP) { atomicAdd(&bar[XB_TMO], 1u); break; } }
    }
    nloc = mine > 0u ? mine : 1u; nx = cnt > 0u ? cnt : 1u;
}
__device__ __forceinline__ void xcd_barrier(const XcdBarrier& b, int tid) {
    asm volatile("s_waitcnt vmcnt(0)" ::: "memory");
    __syncthreads();
    if (tid == 0) {
        unsigned* bar = b.bar;
        __builtin_amdgcn_s_waitcnt(0);
        unsigned nloc = b.st[0], nx = b.st[1];
        if (nloc == 0u) { xcd_barrier_complete(bar, b.x, nloc, nx); b.st[0] = nloc; b.st[1] = nx; }
        const unsigned old = xb_add(&bar[XB_XSUB(b.x)], 1u);
        const unsigned gen = old / nloc;
        if (old + 1u == (gen + 1u) * nloc) {
            __builtin_amdgcn_fence(__ATOMIC_RELEASE, "agent");
            asm volatile("s_waitcnt vmcnt(0)" ::: "memory");
            const unsigned og = xb_add(&bar[XB_TOP], 1u);
            const unsigned tg = og / nx;
            if (og + 1u == (tg + 1u) * nx) xb_add(&bar[XB_TOPGEN], 1u);
            else XB_SPIN(xb_ld(&bar[XB_TOPGEN]) == tg, bar);
            __builtin_amdgcn_fence(__ATOMIC_ACQUIRE, "agent");
            xb_add(&bar[XB_XGEN(b.x)], 1u);
            asm volatile("s_waitcnt vmcnt(0)" ::: "memory");
        } else {
            XB_SPIN(xb_ld(&bar[XB_XGEN(b.x)]) == gen, bar);
            __builtin_amdgcn_fence(__ATOMIC_ACQUIRE, "agent");
            asm volatile("s_waitcnt vmcnt(0)" ::: "memory");
        }
    }
    __syncthreads();
}

#ifndef TIER_FFN
#define TIER_FFN 1
#endif
#ifndef TIER_MLSTM
#define TIER_MLSTM 1
#endif
#ifndef TIER_SB
#define TIER_SB 1
#endif
#ifndef TIER_PLE
#define TIER_PLE 1
#endif
#ifndef F_PER_PHASE
#define F_PER_PHASE 0
#endif
struct WsMap { size_t lo, ctl, wgu, wd, wmt, wmr, wmg, wmo, wk, wv, wq, wo, wpg, wpe, hb, ss, pb, pj, kvk, kvv, gates, chs, mprev, scratch; };
constexpr size_t SC_HID = 0, SC_TOK = 0, SC_TR = (size_t)M * 4096 * 2, SC_U = SC_TR + (size_t)2048 * M * 2, SC_CST = SC_U + (size_t)256 * 520 * 256 * 2, SC_END = SC_CST + (size_t)256 * 528 * 256 * 2;
constexpr size_t SC_HS = SC_U, SC_Q = 0, SC_OATT = (size_t)M * D * 2;
constexpr size_t WGU_SZ = (size_t)2 * DFF * D * 2, WD_SZ = (size_t)D * DFF * 2, WDD_SZ = (size_t)D * D * 2, WMT_SZ = (size_t)4096 * D * 2, WMR_SZ = (size_t)2048 * D * 2, WMG_SZ = 8 * D * 4, WPE_SZ = (size_t)D * DPLE * 2;
constexpr size_t HB_SZ = (size_t)M * D * 2, SS_SZ = (size_t)M * 32 * 4, PB_SZ = (size_t)M * DPLE * 2;
constexpr size_t CTL_BYTES = 1u << 20;
constexpr size_t align_up(size_t x) { return (x + 255) & ~(size_t)255; }
constexpr size_t max_sz(size_t a, size_t b) { return a > b ? a : b; }
struct HostPlan { WsMap m; size_t s_hn, s_t, s_kv, total; };
constexpr HostPlan make_plan() {
    HostPlan p{}; size_t o = 0;
#define TAKE(dst, bytes) do { dst = o; o = align_up(o + (bytes)); } while (0)
    const bool anyF = TIER_FFN || TIER_MLSTM || TIER_SB || TIER_PLE;
    TAKE(p.m.ctl, CTL_BYTES);
    if (TIER_FFN) { TAKE(p.m.wgu, 8 * WGU_SZ); TAKE(p.m.wd, 8 * WD_SZ); }
    if (TIER_MLSTM) { TAKE(p.m.wmt, 2 * WMT_SZ); TAKE(p.m.wmr, 2 * WMR_SZ); TAKE(p.m.wmg, 2 * WMG_SZ); TAKE(p.m.wmo, 2 * WDD_SZ); TAKE(p.m.gates, (size_t)M * 8 * 4); TAKE(p.m.chs, 4096); TAKE(p.m.mprev, 4096); }
    if (TIER_SB) { TAKE(p.m.wk, WDD_SZ); TAKE(p.m.wv, WDD_SZ); TAKE(p.m.wq, 2 * WDD_SZ); TAKE(p.m.wo, 2 * WDD_SZ); TAKE(p.m.kvk, HB_SZ); TAKE(p.m.kvv, HB_SZ); }
    if (TIER_PLE) { TAKE(p.m.wpg, 4 * WDD_SZ); TAKE(p.m.wpe, 4 * WPE_SZ); TAKE(p.m.pb, 4 * PB_SZ); TAKE(p.m.pj, HB_SZ); }
    if (anyF) { TAKE(p.m.hb, 2 * HB_SZ); TAKE(p.m.ss, 2 * SS_SZ); if (RESID_LO) TAKE(p.m.lo, HB_SZ); }
    size_t scr = 0;
    if (TIER_FFN) scr = max_sz(scr, (size_t)M * DFF * 2);
    if (TIER_MLSTM) scr = max_sz(scr, SC_END);
    if (TIER_SB) scr = max_sz(scr, 2 * HB_SZ);
    const bool anyS = !(TIER_FFN && TIER_MLSTM && TIER_SB && TIER_PLE);
    if (anyS) scr = max_sz(scr, align_up(S_HN_BYTES) + align_up(S_T_BYTES));
    TAKE(p.m.scratch, scr);
    p.s_hn = p.m.scratch; p.s_t = p.m.scratch + align_up(S_HN_BYTES);
    if (!TIER_SB) TAKE(p.s_kv, S_KV_BYTES);
    p.total = o;
#undef TAKE
    return p;
}
constexpr HostPlan PLAN = make_plan();
constexpr size_t WS_CTL = PLAN.m.ctl, WS_WGU = PLAN.m.wgu, WS_WD = PLAN.m.wd, WS_WMT = PLAN.m.wmt, WS_WMR = PLAN.m.wmr, WS_WMG = PLAN.m.wmg, WS_WMO = PLAN.m.wmo, WS_WK = PLAN.m.wk, WS_WV = PLAN.m.wv, WS_WQ = PLAN.m.wq, WS_WO = PLAN.m.wo,
                 WS_WPG = PLAN.m.wpg, WS_WPE = PLAN.m.wpe, WS_HB = PLAN.m.hb, WS_SS = PLAN.m.ss, WS_PB = PLAN.m.pb, WS_PJ = PLAN.m.pj, WS_KVK = PLAN.m.kvk, WS_KVV = PLAN.m.kvv, WS_GATES = PLAN.m.gates, WS_CHS = PLAN.m.chs, WS_MPREV = PLAN.m.mprev,
                 WS_SCRATCH = PLAN.m.scratch, WS_LO = PLAN.m.lo, WS_GQ = PLAN.m.ctl + CTL_BYTES - 4096;
constexpr int CW_BAR = 4096;
constexpr int PID_PRO = 0, PID_S0 = 8, PID_KVONLY = PID_S0 + 16 * 8, PID_END = PID_KVONLY + 8;
enum StageType { ST_FFN = 0, ST_MLSTM = 1, ST_SB = 2, ST_PLE = 3, ST_KVONLY = 4 };
__host__ __device__ inline int stage_type(int s) { if (s >= 16) return ST_KVONLY; const int layer = s >> 2, k = s & 3; return (k == 0 || k == 2) ? ST_FFN : (k == 3 ? ST_PLE : (layer < 2 ? ST_MLSTM : ST_SB)); }
#define PROJ_IN_FFN (TIER_FFN && TIER_PLE)
__host__ __device__ inline bool slot_active(int type, int slot) {
    if (slot == 0) return !(type == ST_PLE && PROJ_IN_FFN);
    if (type == ST_KVONLY) return false;
    if (slot == 4) return true;
    if (type == ST_MLSTM) return slot >= 1 && slot <= 3;
    if (type == ST_SB) return slot == 1;
    return false;
}
struct Args { const float* in[20]; float* out; unsigned char* ws; int ph_lo, ph_hi, ph_last, bar_region, cur_lo, kv_in_ffn, pad0, pad1; };
constexpr int INL_OFF = MISC_OFF + 256;
static_assert(INL_OFF + 256 <= LDS_BYTES, "LDS map");

struct Frame {
    LAS unsigned char* lds; int tid, lane, wave, G;
};
__device__ __forceinline__ const float* inptr(const Frame& F, int i) {
    u32x2 v; const unsigned addr = (unsigned)(size_t)(F.lds + INL_OFF) + 8u * (unsigned)i;
    asm volatile("ds_read_b64 %0, %1\n\ts_waitcnt lgkmcnt(0)" : "=&v"(v) : "v"(addr) : "memory");
    const unsigned long long p = ((unsigned long long)(unsigned)__builtin_amdgcn_readfirstlane((int)v.y) << 32) | (unsigned)__builtin_amdgcn_readfirstlane((int)v.x);
    return (const float*)(const GAS float*)p;
}
__device__ __forceinline__ float wave_max(float v) {
#pragma unroll
    for (int o = 1; o < 64; o <<= 1) v = fmaxf(v, __shfl_xor(v, o));
    return v;
}
template <int OP> __device__ __forceinline__ float block_scan256(float v, LAS float* scr, int tid) {
    const int lane = tid & 63, w = tid >> 6;
#pragma unroll
    for (int off = 1; off < 64; off <<= 1) { const float t = __shfl_up(v, off); if (lane >= off) v = OP ? fmaxf(v, t) : v + t; }
    __syncthreads();
    if (lane == 63 && w < 4) scr[w] = v;
    __syncthreads();
    if (w > 0 && w < 4) { float o = scr[0]; for (int i = 1; i < w; ++i) o = OP ? fmaxf(o, scr[i]) : o + scr[i]; v = OP ? fmaxf(v, o) : v + o; }
    return v;
}

struct ConvDesc { const float* W; const float* gain; bf16* dst; int ldw, col0, nblk, K, drow0, il, item; float cs; };
__device__ __forceinline__ void conv_item(const ConvDesc& d, LAS float* scr, int lane) {
    const int kb = d.item / d.nblk, nb = d.item % d.nblk, k0 = 64 * kb, n0 = 64 * nb;
    const int r = lane >> 4, c4 = lane & 15;
    f32x4 v[16]; float gs[16];
    const float* wp = d.W + (size_t)(k0 + r) * d.ldw + d.col0 + n0 + 4 * c4;
#pragma unroll
    for (int i = 0; i < 16; ++i) v[i] = *(const f32x4*)(wp + (size_t)(4 * i) * d.ldw);
#pragma unroll
    for (int i = 0; i < 16; ++i) gs[i] = d.gain ? d.gain[k0 + 4 * i + r] * d.cs : d.cs;
#pragma unroll
    for (int i = 0; i < 16; ++i) { const int k = 4 * i + r; *(LAS f32x4*)(scr + k * 64 + ((c4 ^ ((k >> 3) & 7)) * 4)) = v[i] * gs[i]; }
    LDS_WAIT(); asm volatile("" ::: "memory");
    const int c = lane & 7;
    const int dr0 = d.il ? (256 * (n0 >> 7) + 128 * (d.il - 1) + (n0 & 127)) : (d.drow0 + n0);
#pragma unroll
    for (int jj = 0; jj < 8; ++jj) { const int n = (lane >> 3) + 8 * jj; const LAS float* s = scr + (8 * c) * 64 + (((n >> 2) ^ c) * 4) + (n & 3);
        u32x4 o; o.x = cvtpk(s[0 * 64], s[1 * 64]); o.y = cvtpk(s[2 * 64], s[3 * 64]); o.z = cvtpk(s[4 * 64], s[5 * 64]); o.w = cvtpk(s[6 * 64], s[7 * 64]);
        *(u32x4*)(d.dst + (size_t)(dr0 + n) * d.K + k0 + 8 * c) = o; }
    LDS_WAIT(); asm volatile("" ::: "memory");
}
constexpr int CV_FFN1 = (D / 64) * (DFF / 64), CV_FFN = 8 * 3 * CV_FFN1, CV_ML1 = 4096, CV_ML = 2 * CV_ML1, CV_KV = 2048, CV_SB = 4096, CV_PLE1 = 1152, CV_PLE = 4 * CV_PLE1, CV_TOTAL = CV_FFN + CV_ML + CV_KV + CV_SB + CV_PLE;
__device__ __forceinline__ ConvDesc conv_decode(const Frame& F, unsigned char* ws, int it) {
    ConvDesc d; d.W = nullptr; d.gain = nullptr; d.dst = nullptr; d.ldw = D; d.col0 = 0; d.nblk = D / 64; d.K = D; d.drow0 = 0; d.il = 0; d.item = 0; d.cs = 1.f;
    if (it < CV_FFN) {
        if (!TIER_FFN) return d;
        const int wi = it / (3 * CV_FFN1), r = it % (3 * CV_FFN1), mat = r / CV_FFN1; d.item = r % CV_FFN1;
        if (mat < 2) { d.W = inptr(F, 3 + mat) + (size_t)wi * D * DFF; d.ldw = DFF; d.nblk = DFF / 64; d.dst = (bf16*)(ws + WS_WGU + (size_t)wi * WGU_SZ); d.il = 1 + mat; d.gain = inptr(F, 2) + wi * D; }
        else { d.W = inptr(F, 5) + (size_t)wi * DFF * D; d.K = DFF; d.dst = (bf16*)(ws + WS_WD + (size_t)wi * WD_SZ); }
        return d;
    }
    it -= CV_FFN;
    if (it < CV_ML) {
        if (!TIER_MLSTM) return d;
        const int l = it / CV_ML1, r = it % CV_ML1; d.W = inptr(F, 7) + (size_t)l * D * MPROJ; d.ldw = MPROJ; d.gain = inptr(F, 6) + l * D;
        bf16* mt = (bf16*)(ws + WS_WMT + (size_t)l * WMT_SZ); bf16* mr = (bf16*)(ws + WS_WMR + (size_t)l * WMR_SZ);
        if (r < 512) { d.nblk = 16; d.dst = mt; d.cs = 0.0625f; d.item = r; }
        else if (r < 1024) { d.col0 = 1024; d.nblk = 16; d.dst = mt; d.drow0 = 1024; d.item = r - 512; }
        else if (r < 2048) { d.col0 = 4096; d.dst = mt; d.drow0 = 2048; d.item = r - 1024; }
        else if (r < 3072) { d.col0 = 2048; d.dst = mr; d.item = r - 2048; }
        else { d.W = inptr(F, 10) + (size_t)l * D * D; d.ldw = D; d.gain = nullptr; d.dst = (bf16*)(ws + WS_WMO + (size_t)l * WDD_SZ); d.item = r - 3072; }
        return d;
    }
    it -= CV_ML;
    if (it < CV_KV) {
        if (!TIER_SB) return d;
        d.W = inptr(F, 12); d.ldw = 4096; d.gain = inptr(F, 11);
        if (it < 1024) { d.dst = (bf16*)(ws + WS_WK); d.item = it; } else { d.col0 = 2048; d.dst = (bf16*)(ws + WS_WV); d.item = it - 1024; }
        return d;
    }
    it -= CV_KV;
    if (it < CV_SB) {
        if (!TIER_SB) return d;
        const int j = it / 2048, r = it % 2048;
        if (r < 1024) { d.W = inptr(F, 14) + (size_t)j * D * D; d.gain = inptr(F, 6) + (2 + j) * D; d.dst = (bf16*)(ws + WS_WQ + (size_t)j * WDD_SZ); d.item = r; }
        else { d.W = inptr(F, 16) + (size_t)j * D * D; d.dst = (bf16*)(ws + WS_WO + (size_t)j * WDD_SZ); d.item = r - 1024; }
        return d;
    }
    it -= CV_SB;
    if (!TIER_PLE) return d;
    { const int l = it / CV_PLE1, r = it % CV_PLE1;
      if (r < 1024) { d.W = inptr(F, 19) + (size_t)l * D * D; d.gain = inptr(F, 17) + l * D; d.dst = (bf16*)(ws + WS_WPG + (size_t)l * WDD_SZ); d.item = r; }
      else { d.W = inptr(F, 18) + (size_t)l * DPLE * D; d.K = DPLE; d.dst = (bf16*)(ws + WS_WPE + (size_t)l * WPE_SZ); d.item = r - 1024; } }
    return d;
}
__device__ __forceinline__ void p_prologue(const Frame& F, unsigned char* ws) {
    LAS float* scr = (LAS float*)(F.lds + F.wave * 16384);
    const int gw = blockIdx.x * NWAVES + F.wave, NGW = F.G * NWAVES;
#pragma unroll 1
    for (int it = gw; it < CV_TOTAL; it += NGW) { const ConvDesc d = conv_decode(F, ws, it); if (d.W != nullptr) conv_item(d, scr, F.lane); }
    if (TIER_MLSTM) for (int l = 0; l < 2; ++l) {
        const float* win = inptr(F, 7) + (size_t)l * D * MPROJ; const float* g = inptr(F, 6) + l * D; float* wg = (float*)(ws + WS_WMG + (size_t)l * WMG_SZ);
        for (int i = blockIdx.x * 512 + F.tid; i < 8 * D; i += F.G * 512) { const int gi = i / D, k = i % D; wg[i] = win[(size_t)k * MPROJ + 6144 + gi] * g[k]; }
    }
    if (TIER_PLE) { const f32x4* src = (const f32x4*)inptr(F, 1); u32x4* dst = (u32x4*)(ws + WS_PB); const size_t n8 = (size_t)DEPTH * M * DPLE / 8;
      for (size_t i = (size_t)blockIdx.x * 512 + F.tid; i < n8; i += (size_t)F.G * 512) { const f32x4 v0 = src[2 * i], v1 = src[2 * i + 1];
          u32x4 w; w.x = cvtpk(v0[0], v0[1]); w.y = cvtpk(v0[2], v0[3]); w.z = cvtpk(v1[0], v1[1]); w.w = cvtpk(v1[2], v1[3]); dst[i] = w; } }
}
__device__ __forceinline__ void sync_rows(const float* src, bf16* hi, bf16* lo, float* ss, int gw, int NGW, int lane) {
    for (int row = gw; row < M; row += NGW) {
        const f32x4* xr = (const f32x4*)(src + (size_t)row * D); f32x4 v[8]; float s = 0.f;
#pragma unroll
        for (int j = 0; j < 4; ++j) { v[2 * j] = xr[2 * lane + 128 * j]; v[2 * j + 1] = xr[2 * lane + 128 * j + 1]; }
#pragma unroll
        for (int j = 0; j < 8; ++j) s += (v[j][0] * v[j][0] + v[j][1] * v[j][1]) + (v[j][2] * v[j][2] + v[j][3] * v[j][3]);
        s = wave_sum(s);
        u32x4* br = (u32x4*)(hi + (size_t)row * D); u32x4* lr = (u32x4*)(lo + (size_t)row * D);
#pragma unroll
        for (int j = 0; j < 4; ++j) { const f32x4 a0 = v[2 * j], a1 = v[2 * j + 1];
            u32x4 w; w.x = cvtpk(a0[0], a0[1]); w.y = cvtpk(a0[2], a0[3]); w.z = cvtpk(a1[0], a1[1]); w.w = cvtpk(a1[2], a1[3]);
            u32x4 l; l.x = cvtpk(a0[0] - bf_lo(w.x), a0[1] - bf_hi(w.x)); l.y = cvtpk(a0[2] - bf_lo(w.y), a0[3] - bf_hi(w.y)); l.z = cvtpk(a1[0] - bf_lo(w.z), a1[1] - bf_hi(w.z)); l.w = cvtpk(a1[2] - bf_lo(w.w), a1[3] - bf_hi(w.w));
            br[lane + 64 * j] = w; if (RESID_LO) lr[lane + 64 * j] = l; }
        if (lane < 32) ss[(size_t)row * 32 + lane] = (lane == 0) ? s : 0.f;
    }
}
__global__ __launch_bounds__(256) void k_f_sync(const float* h, bf16* hb, bf16* lo, float* ss) {
    sync_rows(h, hb, lo, ss, blockIdx.x * 4 + (threadIdx.x >> 6), gridDim.x * 4, threadIdx.x & 63);
}

__device__ __forceinline__ float logsigmoid_hw(float x) { const float e = __expf(-fabsf(x)), w = 1.0f + e; const float l = (w == 1.0f) ? e : __logf(w) * (e / (w - 1.0f)); return fminf(x, 0.f) - l; }
__device__ __forceinline__ void p_gates(const Frame& F, const bf16* hb, const float* ss, const float* wg, const float* bif, float* gates) {
    LAS float* W = (LAS float*)F.lds;
    __syncthreads();
    for (int i = F.tid; i < 8 * D / 4; i += NWAVES * 64) ((LAS f32x4*)W)[i] = ((const f32x4*)wg)[i];
    __syncthreads();
    const int gw = blockIdx.x * NWAVES + F.wave, NGW = F.G * NWAVES, lane = F.lane;
    for (int row = gw; row < M; row += 2 * NGW) {
        const int row1 = (row + NGW < M) ? row + NGW : row;
        float sq0 = (lane < 32) ? ss[(size_t)row * 32 + lane] : 0.f, sq1 = (lane < 32) ? ss[(size_t)row1 * 32 + lane] : 0.f;
        u32x2 h0[8], h1[8];
#pragma unroll
        for (int j = 0; j < 8; ++j) { h0[j] = *(const u32x2*)(hb + (size_t)row * D + 4 * lane + 256 * j); h1[j] = *(const u32x2*)(hb + (size_t)row1 * D + 4 * lane + 256 * j); }
        sq0 = wave_sum(sq0); sq1 = wave_sum(sq1);
        float a0[8], a1[8];
#pragma unroll
        for (int g = 0; g < 8; ++g) { a0[g] = 0.f; a1[g] = 0.f; }
#pragma unroll
        for (int j = 0; j < 8; ++j) {
            const float x0 = bf_lo(h0[j].x), x1 = bf_hi(h0[j].x), x2 = bf_lo(h0[j].y), x3 = bf_hi(h0[j].y);
            const float y0 = bf_lo(h1[j].x), y1 = bf_hi(h1[j].x), y2 = bf_lo(h1[j].y), y3 = bf_hi(h1[j].y);
#pragma unroll
            for (int g = 0; g < 8; ++g) { const f32x4 w = *(const LAS f32x4*)(W + g * D + 4 * lane + 256 * j);
                a0[g] += (x0 * w[0] + x1 * w[1]) + (x2 * w[2] + x3 * w[3]); a1[g] += (y0 * w[0] + y1 * w[1]) + (y2 * w[2] + y3 * w[3]); }
            asm volatile("" ::: "memory");
        }
        float mine = 0.f;
#pragma unroll
        for (int g = 0; g < 8; ++g) { const float t0 = wave_sum(a0[g]), t1 = wave_sum(a1[g]); if (lane == g) mine = t0; if (lane == 8 + g) mine = t1; }
        if (lane < 16 && (lane < 8 || row1 != row)) { const int gi = lane & 7; const int r = (lane < 8) ? row : row1; const float sq = (lane < 8) ? sq0 : sq1;
            const float pre = mine * (1.0f / sqrtf(sq * (1.0f / D) + EPS)) + bif[gi]; gates[(size_t)r * 8 + gi] = (gi < 4) ? pre : logsigmoid_hw(pre); }
    }
}


typedef float f32x16_t __attribute__((ext_vector_type(16)));
#define MFMA32(a, b, c) __builtin_amdgcn_mfma_f32_32x32x16_bf16((a), (b), (c), 0, 0, 0)
#define MFMA16(a, b, c) __builtin_amdgcn_mfma_f32_16x16x32_bf16((a), (b), (c), 0, 0, 0)

typedef short v4i16_t __attribute__((ext_vector_type(4)));
__device__ __forceinline__ unsigned offb(unsigned row, unsigned ch) { return 256u * row + 16u * (ch ^ (((row & 3u) << 2) | ((row >> 2) & 3u))); }
__device__ __forceinline__ void p_mlstm_a(const Frame& F, const float* gates, const bf16* tok, const bf16* vT, bf16* U, float* chs) {
    LAS unsigned char* L = F.lds;
    LAS float* wtab = (LAS float*)(L + TAB_OFF); LAS float* scr = wtab + 256;
    const int wave = F.wave;
    for (int u = blockIdx.x; u < 256; u += F.G) {
        int lane = F.lane; asm volatile("" : "+v"(lane));
        const int tid = wave * 64 + lane, hq = lane >> 5, l31 = lane & 31;
        const int bh = u >> 5, c = u & 31, b = bh >> 2, h = bh & 3;
        const size_t mbase = (size_t)b * SEQ + (size_t)c * 256;
        float li = 0.f, lf = 0.f;
        if (tid < 256) { li = gates[(mbase + tid) * 8 + h]; lf = gates[(mbase + tid) * 8 + 4 + h]; }
        { const bf16* src = tok + mbase * 4096 + 1024 + h * 256; u32x4 v[16];
          const unsigned goff = (unsigned)((tid >> 5) * 4096 + (tid & 31) * 8);
          const unsigned loff = (unsigned)(((tid & 31) >> 4) * 65536) + offb((unsigned)(tid >> 5), (unsigned)(tid & 15));
#pragma unroll
          for (int i = 0; i < 16; ++i) v[i] = *(const u32x4*)(src + (size_t)i * (16 * 4096) + goff);
#pragma unroll
          for (int i = 0; i < 16; ++i) *(LAS u32x4*)(L + i * (16 * 256) + loff) = v[i]; }
        const float bc = block_scan256<0>(lf, scr, tid);
        const float gt = li - bc;
        const float mxw = wave_max(tid < 256 ? gt : -3.0e38f);
        __syncthreads(); if (lane == 0) scr[8 + wave] = mxw; __syncthreads();
        const float cm = fmaxf(fmaxf(scr[8], scr[9]), fmaxf(scr[10], scr[11]));
        if (tid < 256) wtab[tid] = __expf(gt - cm);
        if (tid == 255) { chs[(bh * 32 + c) * 2] = bc; chs[(bh * 32 + c) * 2 + 1] = cm; }
        __syncthreads();
        bf16* Ub = U + (size_t)(bh * 32 + c) * 520 * 256;
        const unsigned blk = (lane >> 4) & 1, q = (lane & 15) >> 2, p = lane & 3;
#pragma unroll 1
        for (int i = 0; i < 2; ++i) {
            const int task = wave + 8 * i, eb = task >> 1, dh = task & 1;
            f32x16_t acc[2][4];
#pragma unroll
            for (int et = 0; et < 2; ++et)
#pragma unroll
                for (int dt = 0; dt < 4; ++dt)
#pragma unroll
                    for (int r = 0; r < 16; ++r) acc[et][dt][r] = 0.f;
            const bf16* vrow = vT + (size_t)(h * 512 + eb * 64 + l31) * M + mbase + 8 * hq;
            LAS unsigned char* img = L + dh * 65536;
#pragma unroll 1
            for (int kg = 0; kg < 4; ++kg) {
                u32x4 vb[8];
#pragma unroll
                for (int j = 0; j < 4; ++j)
#pragma unroll
                    for (int et = 0; et < 2; ++et) vb[2 * j + et] = *(const u32x4*)(vrow + (size_t)et * 32 * M + 16 * (4 * kg + j));
#pragma unroll
                for (int j = 0; j < 8; ++j) asm volatile("" : "+v"(vb[j]) :: "memory");
#pragma unroll
                for (int j = 0; j < 4; ++j) {
                    const int ks = 4 * kg + j;
                    const f32x4 w0 = *(const LAS f32x4*)(wtab + 16 * ks + 8 * hq), w1 = *(const LAS f32x4*)(wtab + 16 * ks + 8 * hq + 4);
                    bf16x8 af[2], bfr[4];
#pragma unroll
                    for (int et = 0; et < 2; ++et) { u32x4 v = vb[2 * j + et];
                        v.x = cvtpk(bf_lo(v.x) * w0[0], bf_hi(v.x) * w0[1]); v.y = cvtpk(bf_lo(v.y) * w0[2], bf_hi(v.y) * w0[3]);
                        v.z = cvtpk(bf_lo(v.z) * w1[0], bf_hi(v.z) * w1[1]); v.w = cvtpk(bf_lo(v.w) * w1[2], bf_hi(v.w) * w1[3]); af[et] = __builtin_bit_cast(bf16x8, v); }
#pragma unroll
                    for (int dt = 0; dt < 4; ++dt) {
                        const unsigned r0 = 16u * ks + 8u * hq + q, ch = 4u * dt + 2u * blk + (p >> 1);
                        const s16x4 lo = __builtin_bit_cast(s16x4, __builtin_amdgcn_ds_read_tr16_b64_v4i16((LAS v4i16_t*)(img + offb(r0, ch) + 8u * (p & 1))));
                        const s16x4 hi = __builtin_bit_cast(s16x4, __builtin_amdgcn_ds_read_tr16_b64_v4i16((LAS v4i16_t*)(img + offb(r0 + 4u, ch) + 8u * (p & 1))));
                        bfr[dt] = __builtin_shufflevector(lo, hi, 0, 1, 2, 3, 4, 5, 6, 7);
                    }
#pragma unroll
                    for (int et = 0; et < 2; ++et)
#pragma unroll
                        for (int dt = 0; dt < 4; ++dt) acc[et][dt] = MFMA32(af[et], bfr[dt], acc[et][dt]);
                }
            }
#pragma unroll
            for (int et = 0; et < 2; ++et)
#pragma unroll
                for (int dt = 0; dt < 4; ++dt)
#pragma unroll
                    for (int r = 0; r < 16; ++r) { const int e = eb * 64 + et * 32 + (r & 3) + 8 * (r >> 2) + 4 * hq, d = dh * 128 + dt * 32 + l31; Ub[(size_t)e * 256 + d] = (bf16)(cvtpk(acc[et][dt][r], 0.f) & 0xffffu); }
        }
        if (tid < 256) {
            LAS unsigned char* img = L + (tid >> 7) * 65536; const unsigned col = (unsigned)tid & 127u; float s = 0.f;
#pragma unroll 4
            for (int ss = 0; ss < 256; ++ss) { const unsigned short kv = *(const LAS unsigned short*)(img + offb((unsigned)ss, col >> 3) + 2u * (col & 7u)); s += __uint_as_float(((unsigned)kv) << 16) * wtab[ss]; }
            Ub[(size_t)512 * 256 + tid] = (bf16)(cvtpk(s, 0.f) & 0xffffu); }
        __syncthreads();
    }
}
__device__ __forceinline__ void p_mlstm_b(const Frame& F, const bf16* U, const float* chs, bf16* cst, float* mprev) {
    const int ntask = 8 * 528 * 32;
    for (int task = blockIdx.x * 512 + F.tid; task < ntask; task += F.G * 512) {
        const int bh = task / (528 * 32), rem = task % (528 * 32), e = rem >> 5, d0 = (rem & 31) * 8;
        if (e > 512) { const u32x4 z = {0u, 0u, 0u, 0u}; for (int c = 0; c < 32; ++c) *(u32x4*)(cst + ((size_t)(bh * 32 + c) * 528 + e) * 256 + d0) = z; continue; }
        f32x4 s0 = {0.f, 0.f, 0.f, 0.f}, s1 = {0.f, 0.f, 0.f, 0.f}; float m = 0.f;
        for (int c = 0; c < 32; ++c) {
            const float bL = chs[(bh * 32 + c) * 2], cmL = chs[(bh * 32 + c) * 2 + 1];
            u32x4 w; w.x = cvtpk(s0[0], s0[1]); w.y = cvtpk(s0[2], s0[3]); w.z = cvtpk(s1[0], s1[1]); w.w = cvtpk(s1[2], s1[3]);
            *(u32x4*)(cst + ((size_t)(bh * 32 + c) * 528 + e) * 256 + d0) = w;
            if (e == 0 && d0 == 0) mprev[bh * 32 + c] = m;
            const float mn = bL + fmaxf(m, cmL), ad = __expf(m + bL - mn), sc = __expf(bL + cmL - mn);
            const u32x4 uw = *(const u32x4*)(U + ((size_t)(bh * 32 + c) * 520 + e) * 256 + d0);
            const f32x4 u0 = {bf_lo(uw.x), bf_hi(uw.x), bf_lo(uw.y), bf_hi(uw.y)}, u1 = {bf_lo(uw.z), bf_hi(uw.z), bf_lo(uw.w), bf_hi(uw.w)};
            s0 = s0 * ad + u0 * sc; s1 = s1 * ad + u1 * sc; m = mn;
        }
    }
}
__device__ __forceinline__ void p_mlstm_c(const Frame& F, const float* gates, const bf16* tok, const bf16* trb, const bf16* cst, const float* mprev, const float* ghead, bf16* hs) {
    LAS unsigned char* L = F.lds;
    LAS float* gtab = (LAS float*)(L + TAB_OFF); LAS float* Mtab = gtab + 256; LAS float* btab = gtab + 512; LAS float* ntab = gtab + 768; LAS float* scr = gtab + 1024; LAS float* ghtab = gtab + 1280;
    const int wave = F.wave;
    constexpr int KVBUF = 16384 + 32768, VOFF = 16384;
    for (int unit = blockIdx.x; unit < 512; unit += F.G) {
        int lane = F.lane; asm volatile("" : "+v"(lane));
        const int tid = wave * 64 + lane, g = lane >> 4, l15 = lane & 15;
        const int qh = unit >> 8, rest = unit & 255, bh = rest >> 5, c = rest & 31, b = bh >> 2, h = bh & 3;
        const size_t mbase = (size_t)b * SEQ + (size_t)c * 256;
        const bf16* cbase = cst + (size_t)(bh * 32 + c) * 528 * 256;
        float li = 0.f, lf = 0.f;
        if (tid < 256) { li = gates[(mbase + tid) * 8 + h]; lf = gates[(mbase + tid) * 8 + 4 + h]; }
        const float bc = block_scan256<0>(lf, scr, tid);
        const float gt = li - bc;
        const float cmx = block_scan256<1>(tid < 256 ? gt : -3.0e38f, scr, tid);
        const float me = mprev[bh * 32 + c];
        ghtab[tid] = ghead[h * 512 + tid];
        if (tid < 256) { gtab[tid] = gt; Mtab[tid] = fmaxf(me, cmx); btab[tid] = bc; ntab[tid] = __uint_as_float(((unsigned)cbase[512 * 256 + tid]) << 16); }
        __syncthreads();
        const int tl = 128 * qh + 16 * wave + l15;
        const float Mt = Mtab[tl];
        const bf16* qrow = tok + (mbase + tl) * 4096 + h * 256 + 8 * g;
        bf16x8 qf[8];
#pragma unroll
        for (int ks = 0; ks < 8; ++ks) qf[ks] = *(const bf16x8*)(qrow + 32 * ks);
        const int nkt = ((128 * qh + 16 * wave + 15) >> 5) + 1, ktmax = 4 * qh + 4;
        int cof[4];
#pragma unroll
        for (int j = 0; j < 4; ++j) cof[j] = 16 * (4 * (j ^ (l15 >> 2)) + (g ^ (l15 & 3)));
        f32x4 acc[32];
#pragma unroll
        for (int et = 0; et < 32; ++et) acc[et] = (f32x4){0.f, 0.f, 0.f, 0.f};
#pragma unroll
        for (int ps = 0; ps < 2; ++ps) {
            __syncthreads();
            { const char* srcb = (const char*)(cbase + (size_t)(256 * ps) * 256 + (size_t)(32 * wave) * 256); const int rr = lane >> 5, sl = lane & 31;
#pragma unroll
              for (int i = 0; i < 16; ++i) { const unsigned vo = (unsigned)(rr * 512 + ((sl ^ ((2 * i + rr) & 15)) * 16));
                  __builtin_amdgcn_global_load_lds((const unsigned*)(srcb + (size_t)(2 * i) * 512 + vo), (LAS unsigned*)(L + (32 * wave + 2 * i) * 512), 16, 0, 0); } }
            __syncthreads();
#pragma unroll
            for (int et = 0; et < 16; ++et)
#pragma unroll
                for (int ks = 0; ks < 8; ++ks) { acc[16 * ps + et] = MFMA16(*(const LAS bf16x8*)(L + (16 * et + l15) * 512 + cof[ks & 3] + 256 * (ks >> 2)), qf[ks], acc[16 * ps + et]); if ((ks & 3) == 3) asm volatile("" ::: "memory"); }
        }
        { const float winter = __expf(me - Mt);
#pragma unroll
          for (int et = 0; et < 32; ++et) acc[et] *= winter; }
        float denp = 0.f;
        const bf16* ksrc = tok + mbase * 4096 + 1024 + h * 256;
        const bf16* vsrc = trb + (size_t)(h * 512) * M + mbase;
        const unsigned kvo0 = (unsigned)((lane >> 5) * 8192 + (((lane & 31) ^ ((((4 * wave + (lane >> 5)) >> 3) & 3) << 2 | ((lane >> 5) & 3))) * 16));
        const unsigned vvo = (unsigned)((lane >> 2) * (M * 2) + (((lane & 3) ^ ((lane >> 4) & 3)) * 16));
        const char* kub = (const char*)(ksrc + (size_t)(4 * wave) * 4096); const char* vub = (const char*)(vsrc + (size_t)(64 * wave) * M);
#define STAGE_DMA(kt_, buf_) do { \
            __builtin_amdgcn_global_load_lds((const unsigned*)(kub + (size_t)(32 * (kt_)) * 8192 + kvo0), (LAS unsigned*)(L + (buf_) * KVBUF + (4 * wave) * 512), 16, 0, 0); \
            __builtin_amdgcn_global_load_lds((const unsigned*)(kub + (size_t)(32 * (kt_) + 2) * 8192 + (kvo0 ^ 32u)), (LAS unsigned*)(L + (buf_) * KVBUF + (4 * wave + 2) * 512), 16, 0, 0); \
            _Pragma("unroll") for (int i = 0; i < 4; ++i) \
                __builtin_amdgcn_global_load_lds((const unsigned*)(vub + (size_t)(16 * i) * M * 2 + (size_t)(32 * (kt_)) * 2 + vvo), (LAS unsigned*)(L + (buf_) * KVBUF + VOFF + (64 * wave + 16 * i) * 64), 16, 0, 0); } while (0)
        __syncthreads();
        STAGE_DMA(0, 0);
        const int kr0 = 8 * (l15 >> 2) + (l15 & 3);
#pragma unroll 1
        for (int kt = 0; kt < ktmax; ++kt) {
            __syncthreads();
            if (kt + 1 < ktmax) STAGE_DMA(kt + 1, (kt + 1) & 1);
            if (kt < nkt) {
                LAS unsigned char* KB = L + (kt & 1) * KVBUF; LAS unsigned char* VB = KB + VOFF;
                f32x4 s0 = {0.f, 0.f, 0.f, 0.f}, s1 = {0.f, 0.f, 0.f, 0.f};
#pragma unroll
                for (int ks = 0; ks < 8; ++ks) { const int co = cof[ks & 3] + 256 * (ks >> 2);
                    s0 = MFMA16(*(const LAS bf16x8*)(KB + kr0 * 512 + co), qf[ks], s0); s1 = MFMA16(*(const LAS bf16x8*)(KB + (kr0 + 4) * 512 + co), qf[ks], s1); }
                const int k0 = 32 * kt + 8 * g;
                const f32x4 g0 = *(const LAS f32x4*)(gtab + k0), g1 = *(const LAS f32x4*)(gtab + k0 + 4);
                float p[8];
#pragma unroll
                for (int r = 0; r < 4; ++r) { p[r] = (k0 + r <= tl) ? s0[r] * __expf(g0[r] - Mt) : 0.f; p[4 + r] = (k0 + 4 + r <= tl) ? s1[r] * __expf(g1[r] - Mt) : 0.f; }
                denp += ((p[0] + p[1]) + (p[2] + p[3])) + ((p[4] + p[5]) + (p[6] + p[7]));
                u32x4 pw; pw.x = cvtpk(p[0], p[1]); pw.y = cvtpk(p[2], p[3]); pw.z = cvtpk(p[4], p[5]); pw.w = cvtpk(p[6], p[7]);
                const bf16x8 pf = __builtin_bit_cast(bf16x8, pw);
#pragma unroll
                for (int et = 0; et < 32; ++et) { const int e = 16 * et + l15;
                    acc[et] = MFMA16(*(const LAS bf16x8*)(VB + e * 64 + ((g ^ ((e >> 2) & 3)) * 16)), pf, acc[et]); if ((et & 1) == 1) asm volatile("" ::: "memory"); }
            }
        }
#undef STAGE_DMA
        denp += __shfl_xor(denp, 16); denp += __shfl_xor(denp, 32);
        float dn = 0.f;
#pragma unroll
        for (int ks = 0; ks < 8; ++ks) { const u32x4 qw = __builtin_bit_cast(u32x4, qf[ks]); const f32x4 n0 = *(const LAS f32x4*)(ntab + 32 * ks + 8 * g), n1 = *(const LAS f32x4*)(ntab + 32 * ks + 8 * g + 4);
            dn += (bf_lo(qw.x) * n0[0] + bf_hi(qw.x) * n0[1]) + (bf_lo(qw.y) * n0[2] + bf_hi(qw.y) * n0[3]) + (bf_lo(qw.z) * n1[0] + bf_hi(qw.z) * n1[1]) + (bf_lo(qw.w) * n1[2] + bf_hi(qw.w) * n1[3]); if (ks & 1) asm volatile("" ::: "memory"); }
        dn += __shfl_xor(dn, 16); dn += __shfl_xor(dn, 32); dn *= __expf(me - Mt);
        int tl2 = tl; asm volatile("" : "+v"(tl2));
        const float mt = btab[tl2] + Mt;
        const float inv = 1.0f / fmaxf(fabsf(dn + denp), __expf(-mt));
        float sq = 0.f;
#pragma unroll
        for (int et = 0; et < 32; ++et) { acc[et] *= inv; sq += (acc[et][0] * acc[et][0] + acc[et][1] * acc[et][1]) + (acc[et][2] * acc[et][2] + acc[et][3] * acc[et][3]); }
        sq += __shfl_xor(sq, 16); sq += __shfl_xor(sq, 32);
        const float rn = 1.0f / sqrtf(sq * (1.0f / DV) + EPS);
        const bf16* ogr = tok + (mbase + tl2) * 4096 + 2048 + h * 512 + 4 * g; bf16* hr = hs + (mbase + tl2) * 2048 + h * 512 + 4 * g;
        u32x2 ov[32];
#pragma unroll
        for (int et = 0; et < 32; ++et) ov[et] = *(const u32x2*)(ogr + 16 * et);
#pragma unroll
        for (int et = 0; et < 32; ++et) asm volatile("" : "+v"(ov[et]) :: "memory");
#pragma unroll
        for (int et = 0; et < 32; ++et) {
            const f32x4 gh = *(const LAS f32x4*)(ghtab + 16 * et + 4 * g);
            const float o0 = acc[et][0] * rn * gh[0] * fast_sigmoid(bf_lo(ov[et].x)), o1 = acc[et][1] * rn * gh[1] * fast_sigmoid(bf_hi(ov[et].x)), o2 = acc[et][2] * rn * gh[2] * fast_sigmoid(bf_lo(ov[et].y)), o3 = acc[et][3] * rn * gh[3] * fast_sigmoid(bf_hi(ov[et].y));
            u32x2 w; w.x = cvtpk(o0, o1); w.y = cvtpk(o2, o3); *(u32x2*)(hr + 16 * et) = w; if ((et & 3) == 3) asm volatile("" ::: "memory"); }
        __syncthreads();
    }
}
__device__ __forceinline__ void p_sbattn(const Frame& F, const bf16* q, const bf16* kh, const bf16* vT, bf16* o, const int cap = 1 << 20) {
    const int wave = F.wave;
    LAS unsigned char* WL = F.lds + wave * 16384;
    for (int unit = blockIdx.x; unit < 1024; unit += F.G) {
        int lane = F.lane; asm volatile("" : "+v"(lane));
        const int hq = lane >> 5, l31 = lane & 31, j4 = lane >> 4, p16 = lane & 15;
        const int b = unit >> 9, rem = unit & 511, hd = rem >> 5, qb = rem & 31;
        const int tb = qb * 256 + 32 * wave, t = tb + l31; const size_t rb = (size_t)b * SEQ;
        bf16x8 qf[8];
#pragma unroll
        for (int ks = 0; ks < 8; ++ks) qf[ks] = *(const bf16x8*)(q + (rb + t) * 2048 + hd * 128 + 16 * ks + 8 * hq);
        unsigned kq[4];
#pragma unroll
        for (int c = 0; c < 4; ++c) kq[c] = (unsigned)(j4 * 4096 + (((p16 ^ j4) ^ (4 * c)) * 16));
        const unsigned vq = (unsigned)((lane >> 2) * (M * 2) + ((((lane & 3) ^ ((lane >> 4) & 3))) * 16));
        const char* kub = (const char*)(kh + rb * 2048 + hd * 128); const char* vub = (const char*)(vT + (size_t)(hd * 128) * M + rb);
#define SB_STAGE(s_) do { \
            _Pragma("unroll") for (int i = 0; i < 8; ++i) __builtin_amdgcn_global_load_lds((const unsigned*)(kub + (size_t)((s_) + 16 * (i & 1) + 4 * (i >> 1)) * 4096 + kq[i & 3]), (LAS unsigned*)(WL + i * 1024), 16, 0, 0); \
            _Pragma("unroll") for (int i = 0; i < 8; ++i) __builtin_amdgcn_global_load_lds((const unsigned*)(vub + (size_t)(16 * i) * (M * 2) + (size_t)(s_) * 2 + vq), (LAS unsigned*)(WL + 8192 + i * 1024), 16, 0, 0); } while (0)
        f32x16_t oa[4];
#pragma unroll
        for (int dt = 0; dt < 4; ++dt)
#pragma unroll
            for (int r = 0; r < 16; ++r) oa[dt][r] = 0.f;
        float carry = 1.f;
        const unsigned kra = (unsigned)(l31 * 256), vra = (unsigned)(8192 + l31 * 64), sw16 = (unsigned)(l31 & 15), sw4 = (unsigned)((l31 >> 2) & 3);
        SB_STAGE(tb);
#pragma unroll 1
        for (int s0 = tb; ; s0 -= 32) {
            asm volatile("s_waitcnt vmcnt(0)" ::: "memory");
            bf16x8 kf[8], vf[8];
#pragma unroll
            for (int ks = 0; ks < 8; ++ks) kf[ks] = *(const LAS bf16x8*)(WL + kra + (((unsigned)(2 * ks + hq) ^ sw16) * 16));
#pragma unroll
            for (int sp = 0; sp < 2; ++sp)
#pragma unroll
                for (int dt = 0; dt < 4; ++dt) vf[4 * sp + dt] = *(const LAS bf16x8*)(WL + vra + dt * 2048 + (((unsigned)(2 * hq + sp) ^ sw4) * 16));
#pragma unroll
            for (int ks = 0; ks < 8; ++ks) asm volatile("" : "+v"(kf[ks]), "+v"(vf[ks]));
            asm volatile("s_waitcnt lgkmcnt(0)" ::: "memory");
            if (s0 >= 32) SB_STAGE(s0 - 32);
            f32x16_t z;
#pragma unroll
            for (int r = 0; r < 16; ++r) z[r] = 0.f;
#pragma unroll
            for (int ks = 0; ks < 8; ++ks) z = MFMA32(kf[ks], qf[ks], z);
            float a[16]; float P = 1.f; const int sbase = s0 + 16 * hq;
#pragma unroll
            for (int i = 15; i >= 0; --i) {
                const float zz = fminf(fmaxf(z[i], -80.f), 80.f), e = __expf(-zz), sg = __builtin_amdgcn_rcpf(1.0f + e);
                const bool valid = (sbase + i) < t;
                a[i] = valid ? sg * P : 0.f; P = valid ? P * (e * sg) : P;
            }
            const float Tp = __shfl_xor(P, 32);
            const float fac = carry * (hq == 0 ? Tp : 1.f);
            carry = carry * P * Tp;
#pragma unroll
            for (int sp = 0; sp < 2; ++sp) {
                u32x4 pw; pw.x = cvtpk(a[8 * sp] * fac, a[8 * sp + 1] * fac); pw.y = cvtpk(a[8 * sp + 2] * fac, a[8 * sp + 3] * fac); pw.z = cvtpk(a[8 * sp + 4] * fac, a[8 * sp + 5] * fac); pw.w = cvtpk(a[8 * sp + 6] * fac, a[8 * sp + 7] * fac);
                const bf16x8 pf = __builtin_bit_cast(bf16x8, pw);
#pragma unroll
                for (int dt = 0; dt < 4; ++dt) oa[dt] = MFMA32(vf[4 * sp + dt], pf, oa[dt]);
            }
            if (s0 < 32 || __all(carry == 0.f) || (tb - s0) >= 32 * (cap - 1)) break;
        }
#undef SB_STAGE
        asm volatile("s_waitcnt vmcnt(0)" ::: "memory");
#pragma unroll
        for (int dt = 0; dt < 4; ++dt)
#pragma unroll
            for (int gq = 0; gq < 4; ++gq) { u32x2 w; w.x = cvtpk(oa[dt][4 * gq], oa[dt][4 * gq + 1]); w.y = cvtpk(oa[dt][4 * gq + 2], oa[dt][4 * gq + 3]);
                *(LAS u32x2*)(WL + kra + (((unsigned)(4 * dt + gq) ^ sw16) * 16) + 8 * hq) = w; }
        asm volatile("s_waitcnt lgkmcnt(0)" ::: "memory");
        bf16* ob = o + (rb + tb) * 2048 + hd * 128;
#pragma unroll
        for (int i = 0; i < 8; ++i) { const int row = 4 * i + j4; const u32x4 w = *(const LAS u32x4*)(WL + i * 1024 + lane * 16);
            *(u32x4*)(ob + (size_t)row * 2048 + ((p16 ^ (row & 15)) * 8)) = w; }
        asm volatile("s_waitcnt lgkmcnt(0)" ::: "memory");
    }
}


#ifndef WGM_DN
#define WGM_DN 4
#endif
#ifndef WGM_RES
#define WGM_RES 4
#endif
#ifndef PROBE_REP
#define PROBE_REP 0
#endif
#ifndef PROBE_CAP
#define PROBE_CAP (1 << 20)
#endif
#ifndef PROBE_REP_N
#define PROBE_REP_N 4
#endif
#ifndef GEMM_ALIGN
#define GEMM_ALIGN true
#endif
#define GEMM_PHASE(EPI, g, S, E) pg8::gemm_phase<EPI, pg8::StaticOrder, GEMM_ALIGN, true>(P.lds, g, S, E, P.tid)
#define PHASE_BEGIN Frame P; P.lds = F.lds; P.G = F.G; P.wave = F.wave; { int l_; asm volatile("v_mbcnt_lo_u32_b32 %0, -1, 0\n\tv_mbcnt_hi_u32_b32 %0, -1, %0" : "=v"(l_)); P.lane = l_; P.tid = P.wave * 64 + l_; } \
    GAS unsigned char* wsg_ = (GAS unsigned char*)a.ws; asm volatile("" : "+s"(wsg_)); unsigned char* ws = (unsigned char*)wsg_; GAS float* outg_ = (GAS float*)a.out; asm volatile("" : "+s"(outg_)); float* outp = (float*)outg_; (void)outp; unsigned char* sc = ws + WS_SCRATCH; bf16* hb0 = (bf16*)(ws + WS_HB); float* ss0 = (float*)(ws + WS_SS); \
    const bf16* hb_in = hb0 + (size_t)cur * ((size_t)M * D); const float* ss_in = ss0 + (size_t)cur * ((size_t)M * 32); bf16* hb_out = hb0 + (size_t)(cur ^ 1) * ((size_t)M * D); float* ss_out = ss0 + (size_t)(cur ^ 1) * ((size_t)M * 32); \
    (void)sc; (void)hb_in; (void)ss_in; (void)hb_out; (void)ss_out
__global__ void __launch_bounds__(NWAVES * 64, 2) fwd(Args a) {
    extern __shared__ __attribute__((aligned(16))) unsigned char lds_raw[];
    Frame F; F.lds = (LAS unsigned char*)lds_raw; F.tid = threadIdx.x; F.lane = F.tid & 63; F.wave = __builtin_amdgcn_readfirstlane(F.tid >> 6); F.G = gridDim.x;
    volatile LAS unsigned* MISC = (volatile LAS unsigned*)(F.lds + MISC_OFF);
    if (F.tid < 64) MISC[F.tid] = 0u;
    if (F.tid < 20) ((LAS unsigned long long*)(F.lds + INL_OFF))[F.tid] = (unsigned long long)a.in[F.tid];
    __syncthreads();
    unsigned* ctl = (unsigned*)(a.ws + WS_CTL);
    const XcdBarrier bar = xcd_barrier_post(ctl + CW_BAR + a.bar_region * XCD_BAR_WORDS, MISC + 8, F.tid);
#define SEAM(pid) do { if ((pid) != a.ph_last) xcd_barrier(bar, P.tid); } while (0)
#define RUN(pid) (a.ph_lo <= (pid) && (pid) < a.ph_hi)
    LAS float* tab = (LAS float*)(F.lds + TAB_OFF); LAS float* hnb = (LAS float*)(F.lds + HNB_OFF);

    if (RUN(PID_PRO)) {
        const int cur = 0; PHASE_BEGIN;
        p_prologue(P, ws);
        sync_rows(inptr(P, 0), hb0, (bf16*)(ws + WS_LO), ss0, blockIdx.x * NWAVES + P.wave, P.G * NWAVES, P.lane);
        { const float* qn = inptr(P, 15); float* gq = (float*)(ws + WS_GQ); if (TIER_SB && blockIdx.x == 0 && P.tid < 256) gq[P.tid] = qn[P.tid] * 0.08838834764831845f; }
        SEAM(PID_PRO);
    }
    const int s_first = (a.ph_lo > PID_S0 ? a.ph_lo - PID_S0 : 0) >> 3;
    const int s_end = (a.ph_hi - PID_S0 + 7) >> 3;
#pragma unroll 1
    for (int s = s_first; s < s_end; ++s) {
        const int type = stage_type(s), layer = (s >> 2) & 3, k = s & 3, pid0 = PID_S0 + 8 * s;
        const int cur = (s >= 16) ? a.cur_lo : ((a.cur_lo + (s - s_first)) & 1);
        const int wi = layer * 2 + (k >> 1);
        if (RUN(pid0) && slot_active(type, 0)) {
            PHASE_BEGIN; float* gq = (float*)(ws + WS_GQ);
            const bool kv_here = (type == ST_KVONLY) || (type == ST_FFN && s == 8 && a.kv_in_ffn);
            if (type == ST_FFN) {
                pg8::Gemm g{hb_in, (const bf16*)(ws + WS_WGU + (size_t)wi * WGU_SZ), M, 2 * DFF, D}; pg8::StaticOrder S; S.init(M, 2 * DFF, P.G, (int)blockIdx.x);
                EpiGU E{RstdTab{ss_in, tab, 0}, (bf16*)(sc + SC_HID)};
                GEMM_PHASE(EpiGU, g, S, E);
            }
#pragma unroll 1
            for (int pass = 0; pass < 2; ++pass) {
                pg8::Gemm g{hb_in, nullptr, M, D, D}; EpiTok E{RstdTab{ss_in, tab, 0}, nullptr, D, nullptr, hnb, 0}; bool have = false; int tokG = P.G, tokC = (int)blockIdx.x;
                if (pass == 0) {
                    if (type == ST_MLSTM) { have = true; g.Bt = (const bf16*)(ws + WS_WMT + (size_t)layer * WMT_SZ); g.N = 4096; E.O = (bf16*)(sc + SC_TOK); E.ldo = 4096; }
                    else if (type == ST_SB) { have = true; g.Bt = (const bf16*)(ws + WS_WQ + (size_t)(layer - 2) * WDD_SZ); E.O = (bf16*)(sc + SC_Q); E.gain = gq + (layer - 2) * 128; E.hn = 1; }
                    else if (type == ST_PLE) { have = true; g.A = (const bf16*)(ws + WS_PB + (size_t)layer * PB_SZ); g.Bt = (const bf16*)(ws + WS_WPE + (size_t)layer * WPE_SZ); g.K = DPLE; E.rt.ss = nullptr; E.O = (bf16*)(ws + WS_PJ); }
                    else if (kv_here) { have = true; g.Bt = (const bf16*)(ws + WS_WK); E.O = (bf16*)(ws + WS_KVK); E.gain = inptr(P, 13); E.hn = 1; }
                } else if (PROJ_IN_FFN && type == ST_FFN) {
                    const size_t half = (size_t)(k >> 1) * (M / 2);
                    have = true; g.M = M / 2; g.A = (const bf16*)(ws + WS_PB + (size_t)layer * PB_SZ) + half * DPLE; g.Bt = (const bf16*)(ws + WS_WPE + (size_t)layer * WPE_SZ); g.K = DPLE; E.rt.ss = nullptr; E.O = (bf16*)(ws + WS_PJ) + half * D;
                    tokG = 64; tokC = ((int)blockIdx.x >= P.G - 64) ? (int)blockIdx.x - (P.G - 64) : (1 << 24);
                }
                if (have) { pg8::StaticOrder S; S.init(g.M, g.N, tokG, tokC); GEMM_PHASE(EpiTok, g, S, E); }
            }
            {
                pg8::Gemm g{nullptr, hb_in, 0, M, D}; EpiTr E{RstdTab{ss_in, tab, 1}, nullptr, M}; bool have = false;
                if (type == ST_MLSTM) { have = true; g.A = (const bf16*)(ws + WS_WMR + (size_t)layer * WMR_SZ); g.M = 2048; E.O = (bf16*)(sc + SC_TR); }
                else if (kv_here) { have = true; g.A = (const bf16*)(ws + WS_WV); g.M = D; E.O = (bf16*)(ws + WS_KVV); }
                if (have) { pg8::StaticOrder S; S.init(g.M, g.N, P.G, (int)blockIdx.x); GEMM_PHASE(EpiTr, g, S, E); }
            }
            if (type == ST_MLSTM) p_gates(P, hb_in, ss_in, (const float*)(ws + WS_WMG + (size_t)layer * WMG_SZ), inptr(P, 8) + layer * 8, (float*)(ws + WS_GATES));
            SEAM(pid0);
        }
        if (RUN(pid0 + 1) && slot_active(type, 1)) {
            PHASE_BEGIN;
#pragma unroll 1
            for (int rep = PROBE_REP_N * (((PROBE_REP == 1 && type == ST_MLSTM) || (PROBE_REP == 4 && type == ST_SB)) ? 1 : 0); rep >= 0; --rep) {
            if (rep != PROBE_REP_N * (((PROBE_REP == 1 && type == ST_MLSTM) || (PROBE_REP == 4 && type == ST_SB)) ? 1 : 0)) xcd_barrier(bar, P.tid);
            if (type == ST_MLSTM) p_mlstm_a(P, (const float*)(ws + WS_GATES), (const bf16*)(sc + SC_TOK), (const bf16*)(sc + SC_TR), (bf16*)(sc + SC_U), (float*)(ws + WS_CHS));
            else p_sbattn(P, (const bf16*)(sc + SC_Q), (const bf16*)(ws + WS_KVK), (const bf16*)(ws + WS_KVV), (bf16*)(sc + SC_OATT), (PROBE_REP == 4 && rep == 0) ? (1 << 20) : ((PROBE_REP == 4) ? PROBE_CAP : (1 << 20)));
            }
            SEAM(pid0 + 1);
        }
        if (RUN(pid0 + 2) && slot_active(type, 2)) {
            PHASE_BEGIN;
#pragma unroll 1
            for (int rep = 0; rep < 1 + PROBE_REP_N * ((PROBE_REP == 2) ? 1 : 0); ++rep) {
            if (rep) xcd_barrier(bar, P.tid);
            p_mlstm_b(P, (const bf16*)(sc + SC_U), (const float*)(ws + WS_CHS), (bf16*)(sc + SC_CST), (float*)(ws + WS_MPREV));
            }
            SEAM(pid0 + 2);
        }
        if (RUN(pid0 + 3) && slot_active(type, 3)) {
            PHASE_BEGIN;
#pragma unroll 1
            for (int rep = 0; rep < 1 + PROBE_REP_N * ((PROBE_REP == 3) ? 1 : 0); ++rep) {
            if (rep) xcd_barrier(bar, P.tid);
            p_mlstm_c(P, (const float*)(ws + WS_GATES), (const bf16*)(sc + SC_TOK), (const bf16*)(sc + SC_TR), (const bf16*)(sc + SC_CST), (const float*)(ws + WS_MPREV), inptr(P, 9) + (size_t)layer * (MH * DV), (bf16*)(sc + SC_HS));
            }
            SEAM(pid0 + 3);
        }
        if (RUN(pid0 + 4) && slot_active(type, 4)) {
            PHASE_BEGIN;
            pg8::Gemm g{nullptr, nullptr, M, D, D}; EpiRes E{RstdTab{nullptr, tab, 0}, hb_in, (bf16*)(ws + WS_LO), hb_out, ss_out, outp, 1.0f, nullptr, 0, (s == 15) ? 1 : 0};
            if (type == ST_FFN) { g.A = (const bf16*)(sc + SC_HID); g.Bt = (const bf16*)(ws + WS_WD + (size_t)wi * WD_SZ); g.K = DFF; E.alpha = 0.5f; }
            else if (type == ST_MLSTM) { g.A = (const bf16*)(sc + SC_HS); g.Bt = (const bf16*)(ws + WS_WMO + (size_t)layer * WDD_SZ); }
            else if (type == ST_SB) { g.A = (const bf16*)(sc + SC_OATT); g.Bt = (const bf16*)(ws + WS_WO + (size_t)(layer - 2) * WDD_SZ); }
            else { g.A = hb_in; g.Bt = (const bf16*)(ws + WS_WPG + (size_t)layer * WDD_SZ); E.rt.ss = ss_in; E.pj = (const bf16*)(ws + WS_PJ); E.mode = 1; }
            pg8::StaticOrder S; S.init(M, D, P.G, (int)blockIdx.x, (type == ST_FFN) ? WGM_DN : WGM_RES);
            GEMM_PHASE(EpiRes, g, S, E);
            SEAM(pid0 + 4);
        }
    }
#undef SEAM
#undef RUN
}


#ifndef PROBE_FLAGS
#define PROBE_FLAGS 0
#endif
#ifndef PROBE_DUP
#define PROBE_DUP 0
#endif
static int pid_group(int pid) {
    if (pid == PID_PRO) return 1;
    const int s = (pid - PID_S0) >> 3, slot = (pid - PID_S0) & 7, type = stage_type(s);
    if (slot == 4) return PROBE_DUP >= 9 ? 0 : (type == ST_FFN ? 3 : 7);
    if (slot == 0 && PROBE_DUP >= 9) return (type == ST_SB) ? 13 : 0;
    if (slot == 0 && PROBE_DUP < 9) return type == ST_FFN ? 2 : (type == ST_MLSTM ? 4 : (type == ST_SB ? 6 : 8));
    if (PROBE_DUP >= 9) return type == ST_MLSTM ? 8 + slot : (slot == 1 ? 12 : 0);
    return type == ST_MLSTM ? 5 : 6;
}
static bool pid_active(int pid) {
    if (pid == PID_PRO) return true;
    if (pid < PID_S0 || pid >= PID_END) return false;
    const int s = (pid - PID_S0) >> 3, slot = (pid - PID_S0) & 7;
    return slot < 5 && slot_active(stage_type(s), slot);
}

extern "C" void kernel_launch(void* const* d_in, const int* in_sizes, int n_in, void* d_out, int out_size, void* d_ws, size_t ws_size, hipStream_t stream) {
    constexpr HostPlan plan = PLAN;
    static_assert((TIER_FFN == TIER_MLSTM) && (TIER_FFN == TIER_SB) && (TIER_FFN == TIER_PLE), "the residual stream of the F tier is two bf16 planes: the tiers can no longer be mixed");
    static int grid = 0;
    if (n_in != 20 || out_size != M * D || in_sizes[0] != M * D) { fprintf(stderr, "kernel_launch: unexpected shapes\n"); return; }
    if (ws_size < plan.total) { fprintf(stderr, "kernel_launch: workspace too small (%zu < %zu)\n", ws_size, plan.total); return; }
    const bool anyF = TIER_FFN || TIER_MLSTM || TIER_SB || TIER_PLE;
    if (grid == 0 && anyF) {
        int dev = 0, cus = 0, per_cu = 0;
        if (hipGetDevice(&dev) != hipSuccess || hipDeviceGetAttribute(&cus, hipDeviceAttributeMultiprocessorCount, dev) != hipSuccess) { fprintf(stderr, "kernel_launch: device query failed\n"); grid = -1; return; }
        if (hipFuncSetAttribute((const void*)fwd, hipFuncAttributeMaxDynamicSharedMemorySize, LDS_BYTES) != hipSuccess) { fprintf(stderr, "kernel_launch: hipFuncSetAttribute failed\n"); grid = -1; return; }
        if (hipOccupancyMaxActiveBlocksPerMultiprocessor(&per_cu, (const void*)fwd, NWAVES * 64, LDS_BYTES) != hipSuccess || per_cu < 1) { fprintf(stderr, "kernel_launch: occupancy query says %d blocks per CU\n", per_cu); }
        (void)hipGetLastError();
        grid = cus;
    }
    if (grid < 0) return;
    Inputs in; const float** ip = (const float**)&in;
    for (int i = 0; i < 20; ++i) ip[i] = (const float*)d_in[i];
    float* h = (float*)d_out; unsigned char* ws = (unsigned char*)d_ws;
    float* s_hn = (float*)(ws + plan.s_hn); float* s_t = (float*)(ws + plan.s_t); float* s_kvb = (float*)(ws + plan.s_kv);
    if (anyF) (void)hipMemsetAsync(ws + plan.m.ctl, 0, CTL_BYTES, stream);
    int bar_region = 0, cur = 0; bool hb_valid = false;
    int flo = -1, fhi = -1, fcur = 0;
    auto launchF = [&](int lo, int hi, int last, int cur_lo, bool junk = false, bool probe_launch = false) {
        Args a{};
        for (int i = 0; i < 20; ++i) a.in[i] = (const float*)d_in[i];
        a.out = junk ? (float*)(ws + plan.m.scratch + ((stage_type((lo - PID_S0) >> 3) == ST_MLSTM) ? 0 : (size_t)200 * 1024 * 1024)) : h; a.ws = ws; a.ph_lo = lo; a.ph_hi = hi; a.ph_last = last; a.bar_region = bar_region; a.cur_lo = cur_lo; a.kv_in_ffn = (TIER_SB && TIER_FFN) ? 1 : 0; a.pad0 = 0; a.pad1 = 0;
        hipLaunchKernelGGL(fwd, dim3(grid), dim3(NWAVES * 64), LDS_BYTES, stream, a);
        bar_region = (bar_region + 1) % 48;
    };
    auto flushF = [&]() {
        if (flo < 0) return;
        if (F_PER_PHASE) {
            for (int pid = flo; pid < fhi; ++pid) if (pid_active(pid)) { const int s = pid >= PID_S0 ? (pid - PID_S0) >> 3 : 0; const int s0 = flo >= PID_S0 ? (flo - PID_S0) >> 3 : 0; const int pc = s >= 16 ? fcur : ((fcur + (s - s0)) & 1); if (PROBE_DUP && pid_group(pid) == PROBE_DUP) launchF(pid, pid + 1, pid, pc, ((pid - PID_S0) & 7) == 4 && pid >= PID_S0, true); launchF(pid, pid + 1, pid, pc); }
        } else {
            int last = flo; for (int pid = flo; pid < fhi; ++pid) if (pid_active(pid)) last = pid;
            launchF(flo, fhi, last, fcur);
        }
        flo = -1; fhi = -1;
    };
    auto ensure_sync = [&]() {
        if (!hb_valid) { hipLaunchKernelGGL(k_f_sync, dim3(1024), dim3(256), 0, stream, (const float*)h, (bf16*)(ws + plan.m.hb) + (size_t)cur * ((size_t)M * D), (bf16*)(ws + plan.m.lo), (float*)(ws + plan.m.ss) + (size_t)cur * ((size_t)M * 32)); hb_valid = true; }
    };
    if (anyF) { flo = PID_PRO; fhi = PID_PRO + 1; fcur = 0; cur = 0; hb_valid = true; }
    else hipLaunchKernelGGL(k_s_copy, dim3(2048), dim3(256), 0, stream, h, in.x, (size_t)M * D / 4);
    for (int s = 0; s < 16; ++s) {
        const int type = stage_type(s), layer = s >> 2, k = s & 3;
        const bool tierF = type == ST_FFN ? TIER_FFN : (type == ST_MLSTM ? TIER_MLSTM : (type == ST_SB ? TIER_SB : TIER_PLE));
        if (s == 8) {
            if (TIER_SB) { if (!TIER_FFN) { flushF(); ensure_sync(); flo = PID_KVONLY; fhi = PID_KVONLY + 1; fcur = cur; flushF(); } }
            else { flushF(); s_kv(stream, in, h, s_hn, s_kvb); }
        }
        if (tierF) {
            if (flo < 0) { ensure_sync(); flo = PID_S0 + 8 * s; fcur = cur; }
            fhi = PID_S0 + 8 * s + 8; cur ^= 1; hb_valid = true;
        } else {
            flushF();
            if (type == ST_FFN) s_ffn(stream, in, layer, k >> 1, h, s_hn, s_t);
            else if (type == ST_MLSTM) s_mlstm(stream, in, layer, h, s_hn, s_t);
            else if (type == ST_SB) s_sb(stream, in, layer - 2, layer, h, s_hn, s_t, s_kvb);
            else s_ple(stream, in, layer, h, s_hn, s_t);
            hb_valid = false;
        }
    }
    flushF();
}
```

```cpp
#define TIER_FFN 1
#define TIER_MLSTM 1
#define TIER_SB 1
#define TIER_PLE 1
#define F_PER_PHASE 0
#define PROBE_DUP 0
#define RESID_LO 0
#define PG8_WGM 4
#include <hip/hip_runtime.h>
#include <cstdio>
#include <cstdint>

constexpr int D = 2048, BATCH = 2, SEQ = 8192, M = BATCH * SEQ, DEPTH = 4, DPLE = 256, DFF = 5504;
constexpr int MH = 4, DQK = 256, DV = 512, MPROJ = 2 * MH * DQK + 2 * MH * DV + 2 * MH;
constexpr int SBH = 16, SBD = 128;
constexpr float EPS = 1e-6f;

typedef float f32x16 __attribute__((ext_vector_type(16)));

__device__ __forceinline__ float wave_sum(float v) {
#pragma unroll
    for (int o = 1; o < 64; o <<= 1) v += __shfl_xor(v, o);
    return v;
}
__device__ __forceinline__ float sigmoidf_(float x) { return 1.0f / (1.0f + expf(-x)); }
__device__ __forceinline__ float logsigmoidf_(float x) { return fminf(x, 0.f) - log1pf(expf(-fabsf(x))); }

__global__ __launch_bounds__(256) void k_s_rmsnorm(const float* __restrict__ x, const float* __restrict__ g, float* __restrict__ y, int rows) {
    const int row = blockIdx.x * 4 + (threadIdx.x >> 6), lane = threadIdx.x & 63;
    if (row >= rows) return;
    const float4* xr = (const float4*)(x + (size_t)row * D);
    float4 v[8]; float s = 0.f;
#pragma unroll
    for (int j = 0; j < 8; ++j) { v[j] = xr[lane + 64 * j]; s += v[j].x * v[j].x + v[j].y * v[j].y + v[j].z * v[j].z + v[j].w * v[j].w; }
    s = wave_sum(s);
    const float r = 1.0f / sqrtf(s * (1.0f / D) + EPS);
    const float4* gr = (const float4*)g; float4* yr = (float4*)(y + (size_t)row * D);
#pragma unroll
    for (int j = 0; j < 8; ++j) { const float4 gg = gr[lane + 64 * j]; float4 o; o.x = v[j].x * r * gg.x; o.y = v[j].y * r * gg.y; o.z = v[j].z * r * gg.z; o.w = v[j].w * r * gg.w; yr[lane + 64 * j] = o; }
}

__global__ __launch_bounds__(256) void k_s_headnorm(float* x, int ld, int nheads, int hd, const float* __restrict__ g, int gstride, float scale,
                                                    const float* __restrict__ gate, int gate_ld, int rows) {
    const int w = blockIdx.x * 4 + (threadIdx.x >> 6), lane = threadIdx.x & 63;
    const int row = w / nheads, h = w % nheads;
    if (row >= rows) return;
    float* p = x + (size_t)row * ld + h * hd;
    float s = 0.f;
    for (int e = lane; e < hd; e += 64) { const float v = p[e]; s += v * v; }
    s = wave_sum(s);
    const float r = (1.0f / sqrtf(s / (float)hd + EPS)) * scale;
    for (int e = lane; e < hd; e += 64) {
        float v = p[e] * r * g[h * gstride + e];
        if (gate) v *= sigmoidf_(gate[(size_t)row * gate_ld + h * hd + e]);
        p[e] = v;
    }
}

__global__ __launch_bounds__(256) void k_s_gemm(const float* __restrict__ A, int lda, const float* __restrict__ W, int ldw, float* C, int ldc, int N, int K, float alpha, int accum) {
    __shared__ __attribute__((aligned(16))) float As[16][132];
    __shared__ __attribute__((aligned(16))) float Bs[16][132];
    const int tid = threadIdx.x, lane = tid & 63, wid = tid >> 6, wm = wid >> 1, wn = wid & 1;
    const int m0 = blockIdx.y * 128, n0 = blockIdx.x * 128;
    f32x16 acc[2][2];
#pragma unroll
    for (int i = 0; i < 2; ++i)
#pragma unroll
        for (int j = 0; j < 2; ++j)
#pragma unroll
            for (int r = 0; r < 16; ++r) acc[i][j][r] = 0.f;
    const int arow = tid >> 1, akseg = (tid & 1) * 8;
    const int bk = tid >> 4, bc = (tid & 15) * 8;
    const float* ap = A + (size_t)(m0 + arow) * lda + akseg;
    const float4 z4 = make_float4(0.f, 0.f, 0.f, 0.f);
    for (int k0 = 0; k0 < K; k0 += 16) {
        const float4 a0 = *(const float4*)(ap + k0), a1 = *(const float4*)(ap + k0 + 4);
        const float* wp = W + (size_t)(k0 + bk) * ldw + n0 + bc;
        float4 b0 = z4, b1 = z4;
        if (n0 + bc < N) b0 = *(const float4*)wp;
        if (n0 + bc + 4 < N) b1 = *(const float4*)(wp + 4);
        __syncthreads();
        As[akseg + 0][arow] = a0.x; As[akseg + 1][arow] = a0.y; As[akseg + 2][arow] = a0.z; As[akseg + 3][arow] = a0.w;
        As[akseg + 4][arow] = a1.x; As[akseg + 5][arow] = a1.y; As[akseg + 6][arow] = a1.z; As[akseg + 7][arow] = a1.w;
        *(float4*)&Bs[bk][bc] = b0; *(float4*)&Bs[bk][bc + 4] = b1;
        __syncthreads();
#pragma unroll
        for (int kk = 0; kk < 16; kk += 2) {
            float av[2], bv[2];
#pragma unroll
            for (int i = 0; i < 2; ++i) { av[i] = As[kk + (lane >> 5)][wm * 64 + i * 32 + (lane & 31)]; bv[i] = Bs[kk + (lane >> 5)][wn * 64 + i * 32 + (lane & 31)]; }
#pragma unroll
            for (int i = 0; i < 2; ++i)
#pragma unroll
                for (int j = 0; j < 2; ++j) acc[i][j] = __builtin_amdgcn_mfma_f32_32x32x2f32(av[i], bv[j], acc[i][j], 0, 0, 0);
        }
    }
#pragma unroll
    for (int i = 0; i < 2; ++i)
#pragma unroll
        for (int j = 0; j < 2; ++j)
#pragma unroll
            for (int r = 0; r < 16; ++r) {
                const int row = m0 + wm * 64 + i * 32 + (r & 3) + 8 * (r >> 2) + 4 * (lane >> 5), col = n0 + wn * 64 + j * 32 + (lane & 31);
                if (col < N) { float* p = C + (size_t)row * ldc + col; float v = alpha * acc[i][j][r]; if (accum) v += *p; *p = v; }
            }
}

__global__ void k_s_swiglu(float* __restrict__ G, const float* __restrict__ U, size_t n) {
    for (size_t i = (size_t)blockIdx.x * blockDim.x + threadIdx.x; i < n; i += (size_t)gridDim.x * blockDim.x) { const float g = G[i]; G[i] = g * sigmoidf_(g) * U[i]; }
}
__global__ void k_s_ple(float* __restrict__ h, const float* __restrict__ Pj, const float* __restrict__ Gt, size_t n) {
    for (size_t i = (size_t)blockIdx.x * blockDim.x + threadIdx.x; i < n; i += (size_t)gridDim.x * blockDim.x) h[i] += Pj[i] * sigmoidf_(Gt[i]);
}
__global__ void k_s_copy(float* __restrict__ dst, const float* __restrict__ src, size_t n4) {
    for (size_t i = (size_t)blockIdx.x * blockDim.x + threadIdx.x; i < n4; i += (size_t)gridDim.x * blockDim.x) ((float4*)dst)[i] = ((const float4*)src)[i];
}

__global__ __launch_bounds__(256) void k_s_mlstm(const float* __restrict__ proj, const float* __restrict__ b_if, float* __restrict__ hraw, int S) {
    const int w = blockIdx.x * 4 + (threadIdx.x >> 6), lane = threadIdx.x & 63;
    const int h = w / 128, cg = w % 128, c = lane & 3, dkg = lane >> 2, col = cg * 4 + c;
    const float bi = b_if[h], bf = b_if[MH + h];
    float Cst[16], nst[16];
#pragma unroll
    for (int i = 0; i < 16; ++i) { Cst[i] = 0.f; nst[i] = 0.f; }
    float m = 0.f;
    const float* pq = proj + h * DQK + dkg * 16; const float* pk = proj + MH * DQK + h * DQK + dkg * 16;
    const float* pv = proj + 2 * MH * DQK + h * DV + col; const float* pgi = proj + 2 * MH * DQK + 2 * MH * DV + h; const float* pgf = pgi + MH;
    float4 qn[4], kn[4]; float vn, gin, gfn;
#pragma unroll
    for (int i = 0; i < 4; ++i) { qn[i] = ((const float4*)pq)[i]; kn[i] = ((const float4*)pk)[i]; }
    vn = pv[0]; gin = pgi[0]; gfn = pgf[0];
    for (int t = 0; t < S; ++t) {
        float qf[16], kf[16];
#pragma unroll
        for (int i = 0; i < 4; ++i) { qf[4 * i] = qn[i].x; qf[4 * i + 1] = qn[i].y; qf[4 * i + 2] = qn[i].z; qf[4 * i + 3] = qn[i].w; kf[4 * i] = kn[i].x; kf[4 * i + 1] = kn[i].y; kf[4 * i + 2] = kn[i].z; kf[4 * i + 3] = kn[i].w; }
        const float v = vn, gi = gin, gf = gfn;
        if (t + 1 < S) { const size_t ro = (size_t)(t + 1) * MPROJ;
#pragma unroll
            for (int i = 0; i < 4; ++i) { qn[i] = ((const float4*)(pq + ro))[i]; kn[i] = ((const float4*)(pk + ro))[i]; }
            vn = pv[ro]; gin = pgi[ro]; gfn = pgf[ro]; }
        const float logi = gi + bi, logf = logsigmoidf_(gf + bf);
        const float mn = fmaxf(logf + m, logi);
        const float fd = expf(logf + m - mn), iw = expf(logi - mn);
        float num = 0.f, den = 0.f;
#pragma unroll
        for (int i = 0; i < 16; ++i) { const float kk = iw * kf[i]; Cst[i] = fd * Cst[i] + kk * v; nst[i] = fd * nst[i] + kk; num += qf[i] * Cst[i]; den += qf[i] * nst[i]; }
#pragma unroll
        for (int o = 4; o < 64; o <<= 1) { num += __shfl_xor(num, o); den += __shfl_xor(den, o); }
        num *= 0.0625f; den *= 0.0625f;
        const float hv = num / fmaxf(fabsf(den), expf(-mn));
        m = mn;
        if (dkg == 0) hraw[(size_t)t * (MH * DV) + h * DV + col] = hv;
    }
}

__global__ __launch_bounds__(256) void k_s_sbattn(const float* __restrict__ q, const float* __restrict__ kv, float* __restrict__ o, int S) {
    __shared__ float qs[4][4][SBD];
    const int wv = threadIdx.x >> 6, lane = threadIdx.x & 63;
    const int w = blockIdx.x * 4 + wv, h = w % SBH, t0 = (w / SBH) * 4;
#pragma unroll
    for (int i = 0; i < 8; ++i) { const int idx = lane + 64 * i, qi = idx >> 7, d = idx & 127; qs[wv][qi][d] = q[(size_t)(t0 + qi) * (SBH * SBD) + h * SBD + d]; }
    __syncthreads();
    float carry[4] = {0.f, 0.f, 0.f, 0.f}, oacc[4][2] = {{0.f, 0.f}, {0.f, 0.f}, {0.f, 0.f}, {0.f, 0.f}};
    for (int sb = t0 + 2; sb >= 0; sb -= 64) {
        const int s = sb - lane; const bool valid = s >= 0;
        float z[4] = {0.f, 0.f, 0.f, 0.f};
        if (valid) { const float4* kr = (const float4*)(kv + (size_t)s * (2 * SBH * SBD) + h * SBD);
            for (int d4 = 0; d4 < 32; ++d4) { const float4 kk = kr[d4];
#pragma unroll
                for (int qi = 0; qi < 4; ++qi) { const float* qq = &qs[wv][qi][4 * d4]; z[qi] += kk.x * qq[0] + kk.y * qq[1] + kk.z * qq[2] + kk.w * qq[3]; } } }
        float Aw[4];
#pragma unroll
        for (int qi = 0; qi < 4; ++qi) {
            const bool act = valid && s < t0 + qi;
            const float lb = logsigmoidf_(z[qi]); const float lk = act ? (lb - z[qi]) : 0.f;
            float incl = lk;
#pragma unroll
            for (int off = 1; off < 64; off <<= 1) { const float tv = __shfl_up(incl, off); if (lane >= off) incl += tv; }
            Aw[qi] = act ? expf(lb + carry[qi] + (incl - lk)) : 0.f;
            carry[qi] += __shfl(incl, 63);
        }
        const int nk = (sb + 1 < 64) ? sb + 1 : 64;
        for (int i = 0; i < nk; ++i) {
            const float2 vv = *(const float2*)(kv + (size_t)(sb - i) * (2 * SBH * SBD) + SBH * SBD + h * SBD + 2 * lane);
#pragma unroll
            for (int qi = 0; qi < 4; ++qi) { const float a = __shfl(Aw[qi], i); oacc[qi][0] += a * vv.x; oacc[qi][1] += a * vv.y; }
        }
    }
#pragma unroll
    for (int qi = 0; qi < 4; ++qi) *(float2*)(o + (size_t)(t0 + qi) * (SBH * SBD) + h * SBD + 2 * lane) = make_float2(oacc[qi][0], oacc[qi][1]);
}

struct Inputs {
    const float *x, *p, *ffn_norm, *ffn_wg, *ffn_wu, *ffn_wd, *mix_norm, *m_win, *m_bif, *m_hn, *m_wout, *kv_norm, *w_kv, *k_norm, *w_q, *q_norm, *w_o, *ple_norm, *ple_wp, *ple_wg;
};
static void s_gemm(hipStream_t st, const float* A, int lda, const float* W, int ldw, float* C, int ldc, int rows, int N, int K, float alpha, int accum) {
    dim3 grid((N + 127) / 128, rows / 128);
    hipLaunchKernelGGL(k_s_gemm, grid, dim3(256), 0, st, A, lda, W, ldw, C, ldc, N, K, alpha, accum);
}
constexpr size_t MiB = 1u << 20;
constexpr size_t S_HN_BYTES = (size_t)M * D * 4, S_T_BYTES = (size_t)SEQ * MPROJ * 4, S_KV_BYTES = (size_t)M * 4096 * 4;

static void s_ffn(hipStream_t st, const Inputs& in, int layer, int half, float* h, float* hn, float* T) {
    const size_t wi = (size_t)(layer * 2 + half);
    hipLaunchKernelGGL(k_s_rmsnorm, dim3(M / 4), dim3(256), 0, st, h, in.ffn_norm + wi * D, hn, M);
    const int R = 4096; float* G = T; float* U = T + (size_t)R * DFF;
    for (int r0 = 0; r0 < M; r0 += R) {
        s_gemm(st, hn + (size_t)r0 * D, D, in.ffn_wg + wi * D * DFF, DFF, G, DFF, R, DFF, D, 1.f, 0);
        s_gemm(st, hn + (size_t)r0 * D, D, in.ffn_wu + wi * D * DFF, DFF, U, DFF, R, DFF, D, 1.f, 0);
        hipLaunchKernelGGL(k_s_swiglu, dim3(2048), dim3(256), 0, st, G, U, (size_t)R * DFF);
        s_gemm(st, G, DFF, in.ffn_wd + wi * DFF * D, D, h + (size_t)r0 * D, D, R, D, DFF, 0.5f, 1);
    }
}
static void s_mlstm(hipStream_t st, const Inputs& in, int layer, float* h, float* hn, float* T) {
    hipLaunchKernelGGL(k_s_rmsnorm, dim3(M / 4), dim3(256), 0, st, h, in.mix_norm + (size_t)layer * D, hn, M);
    float* proj = T;
    for (int b = 0; b < BATCH; ++b) {
        float* hraw = hn + (size_t)b * SEQ * D;
        s_gemm(st, hn + (size_t)b * SEQ * D, D, in.m_win + (size_t)layer * D * MPROJ, MPROJ, proj, MPROJ, SEQ, MPROJ, D, 1.f, 0);
        hipLaunchKernelGGL(k_s_mlstm, dim3(MH * 128 / 4), dim3(256), 0, st, proj, in.m_bif + layer * 2 * MH, hraw, SEQ);
        hipLaunchKernelGGL(k_s_headnorm, dim3(SEQ * MH / 4), dim3(256), 0, st, hraw, MH * DV, MH, DV, in.m_hn + (size_t)layer * MH * DV, DV, 1.0f, proj + 2 * MH * DQK + MH * DV, MPROJ, SEQ);
        s_gemm(st, hraw, MH * DV, in.m_wout + (size_t)layer * MH * DV * D, D, h + (size_t)b * SEQ * D, D, SEQ, D, MH * DV, 1.f, 1);
    }
}
static void s_kv(hipStream_t st, const Inputs& in, float* h, float* hn, float* KV) {
    hipLaunchKernelGGL(k_s_rmsnorm, dim3(M / 4), dim3(256), 0, st, h, in.kv_norm, hn, M);
    s_gemm(st, hn, D, in.w_kv, 2 * SBH * SBD, KV, 2 * SBH * SBD, M, 2 * SBH * SBD, D, 1.f, 0);
    hipLaunchKernelGGL(k_s_headnorm, dim3(M * SBH / 4), dim3(256), 0, st, KV, 2 * SBH * SBD, SBH, SBD, in.k_norm, 0, 1.0f, (const float*)nullptr, 0, M);
}
static void s_sb(hipStream_t st, const Inputs& in, int j, int layer, float* h, float* hn, float* T, float* KV) {
    hipLaunchKernelGGL(k_s_rmsnorm, dim3(M / 4), dim3(256), 0, st, h, in.mix_norm + (size_t)layer * D, hn, M);
    float* q = T; float* o = T + (size_t)SEQ * D;
    for (int b = 0; b < BATCH; ++b) {
        s_gemm(st, hn + (size_t)b * SEQ * D, D, in.w_q + (size_t)j * D * D, D, q, D, SEQ, D, D, 1.f, 0);
        hipLaunchKernelGGL(k_s_headnorm, dim3(SEQ * SBH / 4), dim3(256), 0, st, q, SBH * SBD, SBH, SBD, in.q_norm + j * SBD, 0, 0.08838834764831845f, (const float*)nullptr, 0, SEQ);
        hipLaunchKernelGGL(k_s_sbattn, dim3(SBH * (SEQ / 4) / 4), dim3(256), 0, st, q, KV + (size_t)b * SEQ * 4096, o, SEQ);
        s_gemm(st, o, D, in.w_o + (size_t)j * D * D, D, h + (size_t)b * SEQ * D, D, SEQ, D, D, 1.f, 1);
    }
}
static void s_ple(hipStream_t st, const Inputs& in, int layer, float* h, float* hn, float* T) {
    hipLaunchKernelGGL(k_s_rmsnorm, dim3(M / 4), dim3(256), 0, st, h, in.ple_norm + (size_t)layer * D, hn, M);
    const int R = 8192; float* Gt = T; float* Pj = T + (size_t)R * D;
    for (int r0 = 0; r0 < M; r0 += R) {
        s_gemm(st, hn + (size_t)r0 * D, D, in.ple_wg + (size_t)layer * D * D, D, Gt, D, R, D, D, 1.f, 0);
        s_gemm(st, in.p + ((size_t)layer * M + r0) * DPLE, DPLE, in.ple_wp + (size_t)layer * DPLE * D, D, Pj, D, R, D, DPLE, 1.f, 0);
        hipLaunchKernelGGL(k_s_ple, dim3(2048), dim3(256), 0, st, h + (size_t)r0 * D, Pj, Gt, (size_t)R * D);
    }
}

#ifndef PG8_WGM
#define PG8_WGM 8
#endif
namespace pg8 {
#define PG8_LAS __attribute__((address_space(3)))
typedef unsigned short bf16_t;
typedef short bf16x8 __attribute__((ext_vector_type(8)));
typedef float f32x4 __attribute__((ext_vector_type(4)));
typedef unsigned u32x4 __attribute__((ext_vector_type(4)));
constexpr int BM = 256, BK = 64, HALF = 128, HTB = HALF * BK * 2  , STAGE_BYTES = 8 * HTB, NXCD = 8, WGM = PG8_WGM;

__host__ __device__ __forceinline__ int lds_byte(int r, int c) { const int st = (r >> 4) * 2 + (c >> 5), rr = r & 15, cc = c & 31, ob = rr * 64 + cc * 2; return st * 1024 + (ob ^ (((ob >> 9) & 1) << 5)); }
__host__ __device__ __forceinline__ void stage_rc(int b, int& R, int& C) { const int st = b / 1024, sb = b % 1024, swz = sb ^ (((sb >> 9) & 1) << 5); R = (st >> 1) * 16 + swz / 64; C = (st & 1) * 32 + (swz % 64) / 2; }
__host__ __device__ __forceinline__ int perm32(int rho) { const int n = rho >> 4, i = rho & 15; return 8 * (i >> 2) + 4 * n + (i & 3); }

struct Unit { int pm, pn; };
struct Gemm { const bf16_t* A; const bf16_t* Bt; int M, N, K; };

struct StaticOrder {
    int nM, nN, nwg, G, c, wgm;
    __host__ __device__ void init(int M, int N, int G_, int c_, int wgm_ = WGM) { nM = M / BM; nN = N / BM; nwg = nM * nN; G = G_; c = c_; wgm = wgm_; }
    __host__ __device__ bool next(int i, Unit& u) const {
        const long L = (long)i * G + c; if (L >= nwg) return false;
        int wgid = (int)L; { const int q = nwg / NXCD, r = nwg % NXCD, xcd = wgid % NXCD, off = wgid / NXCD; wgid = (xcd < r ? xcd * (q + 1) : r * (q + 1) + (xcd - r) * q) + off; }
        const int nig = wgm * nN, gid = wgid / nig, fm = gid * wgm, gsz = (nM - fm) < wgm ? (nM - fm) : wgm;
        u.pm = fm + ((wgid % nig) % gsz); u.pn = (wgid % nig) / gsz; return true;
    }
    __device__ __forceinline__ void a_ready(const Unit&) const {}
    __device__ __forceinline__ void done(const Unit&) const {}
};


template <class Epi, class Sched, bool ALIGN_EPI = false, bool SP2 = false>
__device__ __forceinline__ void gemm_phase(PG8_LAS unsigned char* lds, const Gemm g, const Sched& S, const Epi& E, const int tid) {
    const int wid = __builtin_amdgcn_readfirstlane(tid >> 6), lane = tid & 63, wr = wid >> 2, wc = wid & 3, fr = lane & 15, fq = lane >> 4;
    const int K = g.K, nt = K / BK;
    unsigned voffA[2], voffB[2];
#pragma unroll
    for (int i = 0; i < 2; ++i) { int R, C; stage_rc(tid * 16 + i * 8192, R, C); const int Rb = Epi::PERM ? ((R & ~31) + perm32(R & 31)) : R;
        voffA[i] = (unsigned)(R * K + C) * 2u; voffB[i] = (unsigned)(Rb * K + C) * 2u; }
    const size_t kstep = (size_t)(BK * 2);
    const size_t hstep = (size_t)HALF * K * 2;
    const size_t tstep = 2 * hstep;
    const unsigned ldsw = (unsigned)wid * 1024u;
    const int aoff = lds_byte(wr * 64 + fr, fq * 8), boff = lds_byte(wc * 32 + fr, fq * 8);
#define PG8_SA(b, h) (((b) * 2 + (h)) * HTB)
#define PG8_SB(b, h) ((4 + (b) * 2 + (h)) * HTB)
#define PG8_STAGE(bufoff, gbase, voff) do { _Pragma("unroll") for (int _i = 0; _i < 2; ++_i) \
        __builtin_amdgcn_global_load_lds((const unsigned*)((const char*)(gbase) + (voff)[_i]), (PG8_LAS unsigned*)(lds + (bufoff) + ldsw + _i * 8192), 16, 0, 0); } while (0)
#define PG8_LDA(dst, b, h) do { _Pragma("unroll") for (int m = 0; m < 4; ++m) _Pragma("unroll") for (int k = 0; k < 2; ++k) dst[m][k] = *(const PG8_LAS bf16x8*)(lds + PG8_SA(b, h) + aoff + m * 2048 + k * 1024); } while (0)
#define PG8_LDB(dst, b, h) do { _Pragma("unroll") for (int n = 0; n < 2; ++n) _Pragma("unroll") for (int k = 0; k < 2; ++k) dst[n][k] = *(const PG8_LAS bf16x8*)(lds + PG8_SB(b, h) + boff + n * 2048 + k * 1024); } while (0)
#define PG8_MMA(ai, bj, At, Bt) do { __builtin_amdgcn_s_setprio(1); _Pragma("unroll") for (int m = 0; m < 4; ++m) _Pragma("unroll") for (int n = 0; n < 2; ++n) _Pragma("unroll") for (int k = 0; k < 2; ++k) \
        acc[ai][bj][m][n] = __builtin_amdgcn_mfma_f32_16x16x32_bf16(Bt[n][k], At[m][k], acc[ai][bj][m][n], 0, 0, 0); __builtin_amdgcn_s_setprio(0); } while (0)
#define PG8_WAIT_V(n) asm volatile("s_waitcnt vmcnt(" #n ")" ::: "memory")
#define PG8_WAIT_L(n) asm volatile("s_waitcnt lgkmcnt(" #n ")" ::: "memory")
#define PG8_BAR __builtin_amdgcn_s_barrier()
#define PG8_SCHED __builtin_amdgcn_sched_barrier(0)
    Unit cur, nxt; int ui = 0;
    if (!S.next(0, cur)) return;
    f32x4 acc[2][2][4][2];
#pragma unroll
    for (int a = 0; a < 2; ++a)
#pragma unroll
        for (int b = 0; b < 2; ++b)
#pragma unroll
            for (int m = 0; m < 4; ++m)
#pragma unroll
                for (int n = 0; n < 2; ++n) acc[a][b][m][n] = (f32x4){0.f, 0.f, 0.f, 0.f};
    bf16x8 At[4][2], B0[2][2], B1[2][2];
    const char* cA = (const char*)g.A + (size_t)cur.pm * tstep; const char* cB = (const char*)g.Bt + (size_t)cur.pn * tstep;
    E.prep_all(S, tid);
    if constexpr (SP2) {
        PG8_STAGE(PG8_SB(0, 0), cB, voffB); PG8_STAGE(PG8_SB(0, 1), cB + hstep, voffB); PG8_STAGE(PG8_SA(0, 0), cA, voffA); PG8_STAGE(PG8_SA(0, 1), cA + hstep, voffA);
        if (wr == 1) PG8_BAR;
        PG8_WAIT_V(2); PG8_BAR;
        PG8_STAGE(PG8_SB(1, 0), cB + kstep, voffB); PG8_STAGE(PG8_SA(1, 0), cA + kstep, voffA); PG8_STAGE(PG8_SB(1, 1), cB + hstep + kstep, voffB);
        PG8_WAIT_V(6); PG8_BAR;
    } else {
        PG8_STAGE(PG8_SB(0, 0), cB, voffB); PG8_STAGE(PG8_SA(0, 0), cA, voffA); PG8_STAGE(PG8_SB(0, 1), cB + hstep, voffB); PG8_STAGE(PG8_SA(0, 1), cA + hstep, voffA);
        if (wr == 1) PG8_BAR;
        PG8_WAIT_V(4); PG8_BAR;
        PG8_STAGE(PG8_SB(1, 0), cB + kstep, voffB); PG8_STAGE(PG8_SA(1, 0), cA + kstep, voffA); PG8_STAGE(PG8_SB(1, 1), cB + hstep + kstep, voffB);
        PG8_WAIT_V(6); PG8_BAR;
    }
    for (;;) {
        const bool has_next = S.next(ui + 1, nxt);
        const char* nA = has_next ? (const char*)g.A + (size_t)nxt.pm * tstep : cA; const char* nB = has_next ? (const char*)g.Bt + (size_t)nxt.pn * tstep : cB;
        for (int t = 0; t < nt; t += 2) {
            const bool last = (t == nt - 2);
            const char* a1 = cA + (size_t)(t + 1) * kstep;
            const char* a2 = last ? nA : cA + (size_t)(t + 2) * kstep; const char* b2 = last ? nB : cB + (size_t)(t + 2) * kstep;
            const char* a3 = a2 + kstep; const char* b3 = b2 + kstep;
            if constexpr (SP2) {
            PG8_LDB(B0, 0, 0); PG8_LDB(B1, 0, 1); PG8_SCHED; PG8_LDA(At, 0, 0); PG8_STAGE(PG8_SA(1, 1), a1 + hstep, voffA);
            PG8_WAIT_V(8); PG8_WAIT_L(0); PG8_BAR; PG8_MMA(0, 0, At, B0); PG8_MMA(0, 1, At, B1); PG8_BAR; PG8_SCHED;
            PG8_LDA(At, 0, 1); PG8_STAGE(PG8_SB(0, 0), b2, voffB); PG8_STAGE(PG8_SB(0, 1), b2 + hstep, voffB); PG8_STAGE(PG8_SA(0, 0), a2, voffA);
            PG8_WAIT_V(8); PG8_WAIT_L(0); PG8_BAR; PG8_MMA(1, 0, At, B0); PG8_MMA(1, 1, At, B1); PG8_BAR; PG8_SCHED;
            PG8_LDB(B0, 1, 0); PG8_LDB(B1, 1, 1); PG8_SCHED; PG8_LDA(At, 1, 0); PG8_STAGE(PG8_SA(0, 1), a2 + hstep, voffA);
            PG8_WAIT_V(8); PG8_WAIT_L(0); PG8_BAR; PG8_MMA(0, 0, At, B0); PG8_MMA(0, 1, At, B1); PG8_BAR; PG8_SCHED;
            PG8_LDA(At, 1, 1); PG8_STAGE(PG8_SB(1, 0), b3, voffB); PG8_STAGE(PG8_SB(1, 1), b3 + hstep, voffB); PG8_STAGE(PG8_SA(1, 0), a3, voffA);
            PG8_WAIT_V(8); PG8_WAIT_L(0); PG8_BAR; PG8_MMA(1, 0, At, B0); PG8_MMA(1, 1, At, B1); PG8_BAR; PG8_SCHED;
            } else {
            PG8_LDB(B0, 0, 0); PG8_SCHED; PG8_LDA(At, 0, 0); PG8_STAGE(PG8_SA(1, 1), a1 + hstep, voffA);
            PG8_WAIT_L(8); PG8_BAR; PG8_WAIT_L(0); PG8_MMA(0, 0, At, B0); PG8_BAR; PG8_SCHED;
            PG8_LDB(B1, 0, 1); PG8_STAGE(PG8_SB(0, 0), b2, voffB);
            PG8_BAR; PG8_WAIT_L(0); PG8_MMA(0, 1, At, B1); PG8_BAR;
            PG8_LDA(At, 0, 1); PG8_STAGE(PG8_SA(0, 0), a2, voffA);
            PG8_BAR; PG8_WAIT_L(0); PG8_MMA(1, 0, At, B0); PG8_BAR; PG8_SCHED;
            PG8_STAGE(PG8_SB(0, 1), b2 + hstep, voffB);
            PG8_WAIT_V(6); PG8_BAR; PG8_MMA(1, 1, At, B1); PG8_BAR;
            PG8_LDB(B0, 1, 0); PG8_SCHED; PG8_LDA(At, 1, 0); PG8_STAGE(PG8_SA(0, 1), a2 + hstep, voffA);
            PG8_WAIT_L(8); PG8_BAR; PG8_WAIT_L(0); PG8_MMA(0, 0, At, B0); PG8_BAR; PG8_SCHED;
            PG8_LDB(B1, 1, 1); PG8_STAGE(PG8_SB(1, 0), b3, voffB);
            PG8_BAR; PG8_WAIT_L(0); PG8_MMA(0, 1, At, B1); PG8_BAR;
            PG8_LDA(At, 1, 1); PG8_STAGE(PG8_SA(1, 0), a3, voffA);
            PG8_BAR; PG8_WAIT_L(0); PG8_MMA(1, 0, At, B0); PG8_BAR; PG8_SCHED;
            PG8_STAGE(PG8_SB(1, 1), b3 + hstep, voffB);
            PG8_WAIT_V(6); PG8_BAR; PG8_MMA(1, 1, At, B1); PG8_BAR;
            }
        }
        if constexpr (ALIGN_EPI) { if (wr == 0) PG8_BAR; }
        E(acc, cur, ui, wr, wc, fr, fq);
        if (!has_next) break;
#pragma unroll
        for (int a = 0; a < 2; ++a)
#pragma unroll
            for (int b = 0; b < 2; ++b)
#pragma unroll
                for (int m = 0; m < 4; ++m)
#pragma unroll
                    for (int n = 0; n < 2; ++n) acc[a][b][m][n] = (f32x4){0.f, 0.f, 0.f, 0.f};
        cur = nxt; cA = nA; cB = nB; ++ui;
        if constexpr (ALIGN_EPI) { if (wr == 1) PG8_BAR; }
    }
    PG8_WAIT_V(0);
    if constexpr (!ALIGN_EPI) { if (wr == 0) PG8_BAR; }
    PG8_BAR;
#undef PG8_SA
#undef PG8_SB
#undef PG8_STAGE
#undef PG8_LDA
#undef PG8_LDB
#undef PG8_MMA
#undef PG8_WAIT_V
#undef PG8_WAIT_L
#undef PG8_BAR
#undef PG8_SCHED
}
}

#define GAS __attribute__((address_space(1)))
#define LAS __attribute__((address_space(3)))
typedef unsigned short bf16;
typedef unsigned u32x4 __attribute__((ext_vector_type(4)));
typedef unsigned u32x2 __attribute__((ext_vector_type(2)));
typedef float f32x4 __attribute__((ext_vector_type(4)));
typedef float f32x2_t __attribute__((ext_vector_type(2)));
typedef __bf16 bf16x2_t __attribute__((ext_vector_type(2)));
typedef short bf16x8 __attribute__((ext_vector_type(8)));
typedef short s16x4 __attribute__((ext_vector_type(4)));
typedef GAS unsigned gu32;
#define RLX_AGENT __ATOMIC_RELAXED, __HIP_MEMORY_SCOPE_AGENT
#define LDS_WAIT() asm volatile("s_waitcnt lgkmcnt(0)" ::: "memory")
#define VM_WAIT() asm volatile("s_waitcnt vmcnt(0)" ::: "memory")

__device__ __forceinline__ unsigned cvtpk(float lo, float hi) { f32x2_t v = {lo, hi}; bf16x2_t b = __builtin_convertvector(v, bf16x2_t); return __builtin_bit_cast(unsigned, b); }
__device__ __forceinline__ float bf_lo(unsigned w) { return __uint_as_float(w << 16); }
__device__ __forceinline__ float bf_hi(unsigned w) { return __uint_as_float(w & 0xffff0000u); }
__device__ __forceinline__ float fast_sigmoid(float x) { return __builtin_amdgcn_rcpf(1.0f + __expf(-x)); }
constexpr int NWAVES = 8;
constexpr int TAB_UNITS = 12;
constexpr int RING_BYTES = 131072, TAB_OFF = RING_BYTES, HNB_OFF = TAB_OFF + TAB_UNITS * 1024, MISC_OFF = HNB_OFF + 8192, LDS_BYTES = MISC_OFF + 512;
static_assert(MISC_OFF + 256 <= LDS_BYTES, "LDS map");

struct RstdTab {
    const float* ss; LAS float* tab; int by_col;
    template <class Sched> __device__ __forceinline__ void prep_all(const Sched& S, int tid) const {
        if (ss == nullptr) return;
#pragma unroll 1
        for (int i0 = 0; i0 < TAB_UNITS; i0 += 2) {
            pg8::Unit u; const int i = i0 + (tid >> 8);
            if (S.next(i, u)) {
                const int idx = (by_col ? u.pn : u.pm) * 256 + (tid & 255);
                const f32x4* p = (const f32x4*)(ss + (size_t)idx * 32);
                f32x4 a = p[0];
#pragma unroll
                for (int k = 1; k < 8; ++k) a += p[k];
                const float s = (a[0] + a[1]) + (a[2] + a[3]);
                tab[i * 256 + (tid & 255)] = 1.0f / sqrtf(s * (1.0f / D) + EPS);
            }
            pg8::Unit u2; if (!S.next(i0 + 2, u2)) break;
        }
    }
};

struct EpiGU {
    static constexpr bool PERM = true;
    RstdTab rt; bf16* H;
    template <class Sched> __device__ __forceinline__ void prep_all(const Sched& S, int tid) const { rt.prep_all(S, tid); }
    __device__ __forceinline__ void operator()(const f32x4 (&acc)[2][2][4][2], const pg8::Unit& u, int ui, int wr, int wc, int fr_, int fq_) const {
        int fr = fr_, fq = fq_; asm volatile("" : "+v"(fr), "+v"(fq));
        const LAS float* tb = rt.tab + ui * 256;
        const int col0 = u.pn * 128 + wc * 32 + 8 * fq;
#pragma unroll
        for (int ai = 0; ai < 2; ++ai)
#pragma unroll
            for (int m = 0; m < 4; ++m) {
                const int r = ai * 128 + wr * 64 + m * 16 + fr; const float rs = tb[r];
                float o[8];
#pragma unroll
                for (int n = 0; n < 2; ++n)
#pragma unroll
                    for (int e = 0; e < 4; ++e) { const float g = acc[ai][0][m][n][e] * rs, up = acc[ai][1][m][n][e] * rs; o[4 * n + e] = g * fast_sigmoid(g) * up; }
                u32x4 w; w.x = cvtpk(o[0], o[1]); w.y = cvtpk(o[2], o[3]); w.z = cvtpk(o[4], o[5]); w.w = cvtpk(o[6], o[7]);
                *(u32x4*)(H + (size_t)(u.pm * 256 + r) * DFF + col0) = w;
            }
    }
};

#ifndef RESID_LO
#define RESID_LO 1
#endif
struct EpiRes {
    static constexpr bool PERM = true;
    RstdTab rt; const bf16* hin; bf16* lo; bf16* hb; float* sso; float* out; float alpha; const bf16* pj; int mode; int final;
    template <class Sched> __device__ __forceinline__ void prep_all(const Sched& S, int tid) const { rt.prep_all(S, tid); }
    __device__ __forceinline__ void operator()(const f32x4 (&acc)[2][2][4][2], const pg8::Unit& u, int ui, int wr, int wc, int fr_, int fq_) const {
        int fr = fr_, fq = fq_; asm volatile("" : "+v"(fr), "+v"(fq));
        const LAS float* tb = rt.tab + ui * 256;
        const int col0 = u.pn * 256 + wc * 32 + 8 * fq;
#pragma unroll
        for (int ai = 0; ai < 2; ++ai)
#pragma unroll
            for (int mb = 0; mb < 2; ++mb) {
                u32x4 hv[2][2], lv[2][2], pv[2][2];
#pragma unroll
                for (int mm = 0; mm < 2; ++mm)
#pragma unroll
                    for (int bj = 0; bj < 2; ++bj) {
                        const size_t off = (size_t)(u.pm * 256 + ai * 128 + wr * 64 + (2 * mb + mm) * 16 + fr) * D + col0 + bj * 128;
                        hv[mm][bj] = *(const u32x4*)(hin + off); lv[mm][bj] = RESID_LO ? *(const u32x4*)(lo + off) : (u32x4){0u, 0u, 0u, 0u};
                        if (mode == 1) pv[mm][bj] = *(const u32x4*)(pj + off);
                    }
                asm volatile("" ::: "memory");
#pragma unroll
                for (int mm = 0; mm < 2; ++mm) {
                    const int m = 2 * mb + mm, r = ai * 128 + wr * 64 + m * 16 + fr; const size_t row = (size_t)(u.pm * 256 + r);
                    float ssq = 0.f;
                    float rs = 1.f; if (mode == 1) rs = tb[r];
#pragma unroll
                    for (int bj = 0; bj < 2; ++bj) {
                        const size_t off = row * D + col0 + bj * 128;
                        const u32x4 hw = hv[mm][bj], lw = lv[mm][bj];
                        float o[8] = {bf_lo(hw.x) + bf_lo(lw.x), bf_hi(hw.x) + bf_hi(lw.x), bf_lo(hw.y) + bf_lo(lw.y), bf_hi(hw.y) + bf_hi(lw.y), bf_lo(hw.z) + bf_lo(lw.z), bf_hi(hw.z) + bf_hi(lw.z), bf_lo(hw.w) + bf_lo(lw.w), bf_hi(hw.w) + bf_hi(lw.w)};
                        if (mode == 0) {
#pragma unroll
                            for (int e = 0; e < 4; ++e) { o[e] += acc[ai][bj][m][0][e] * alpha; o[4 + e] += acc[ai][bj][m][1][e] * alpha; }
                        } else {
                            const u32x4 pw = pv[mm][bj];
                            const float pf[8] = {bf_lo(pw.x), bf_hi(pw.x), bf_lo(pw.y), bf_hi(pw.y), bf_lo(pw.z), bf_hi(pw.z), bf_lo(pw.w), bf_hi(pw.w)};
#pragma unroll
                            for (int e = 0; e < 4; ++e) { o[e] += pf[e] * fast_sigmoid(acc[ai][bj][m][0][e] * rs); o[4 + e] += pf[4 + e] * fast_sigmoid(acc[ai][bj][m][1][e] * rs); }
                        }
                        if (final) { *(f32x4*)(out + off) = (f32x4){o[0], o[1], o[2], o[3]}; *(f32x4*)(out + off + 4) = (f32x4){o[4], o[5], o[6], o[7]}; }
                        else {
                            u32x4 w; w.x = cvtpk(o[0], o[1]); w.y = cvtpk(o[2], o[3]); w.z = cvtpk(o[4], o[5]); w.w = cvtpk(o[6], o[7]);
                            u32x4 l; l.x = cvtpk(o[0] - bf_lo(w.x), o[1] - bf_hi(w.x)); l.y = cvtpk(o[2] - bf_lo(w.y), o[3] - bf_hi(w.y)); l.z = cvtpk(o[4] - bf_lo(w.z), o[5] - bf_hi(w.z)); l.w = cvtpk(o[6] - bf_lo(w.w), o[7] - bf_hi(w.w));
                            *(u32x4*)(hb + off) = w; if (RESID_LO) *(u32x4*)(lo + off) = l;
                            ssq += (o[0] * o[0] + o[1] * o[1]) + (o[2] * o[2] + o[3] * o[3]) + (o[4] * o[4] + o[5] * o[5]) + (o[6] * o[6] + o[7] * o[7]);
                        }
                    }
                    if (!final) { ssq += __shfl_xor(ssq, 16); ssq += __shfl_xor(ssq, 32); if (fq == 0) sso[row * 32 + u.pn * 4 + wc] = ssq; }
                }
            }
    }
};

struct EpiTok {
    static constexpr bool PERM = true;
    RstdTab rt; bf16* O; int ldo; const float* gain; LAS float* hnb; int hn;
    template <class Sched> __device__ __forceinline__ void prep_all(const Sched& S, int tid) const { rt.prep_all(S, tid); }
    __device__ __forceinline__ void operator()(const f32x4 (&acc)[2][2][4][2], const pg8::Unit& u, int ui, int wr, int wc, int fr_, int fq_) const {
        int fr = fr_, fq = fq_; asm volatile("" : "+v"(fr), "+v"(fq));
        const LAS float* tb = rt.tab + ui * 256;
        const int col0 = u.pn * 256 + wc * 32 + 8 * fq;
        float rs[2][4];
#pragma unroll
        for (int ai = 0; ai < 2; ++ai)
#pragma unroll
            for (int m = 0; m < 4; ++m) rs[ai][m] = (rt.ss != nullptr) ? tb[ai * 128 + wr * 64 + m * 16 + fr] : 1.0f;
        f32x4 g0 = {1.f, 1.f, 1.f, 1.f}, g1 = {1.f, 1.f, 1.f, 1.f};
        if (hn) {
            g0 = *(const f32x4*)(gain + wc * 32 + 8 * fq); g1 = *(const f32x4*)(gain + wc * 32 + 8 * fq + 4);
#pragma unroll
            for (int ai = 0; ai < 2; ++ai)
#pragma unroll
                for (int m = 0; m < 4; ++m)
#pragma unroll
                    for (int bj = 0; bj < 2; ++bj) {
                        const f32x4 v0 = acc[ai][bj][m][0] * rs[ai][m], v1 = acc[ai][bj][m][1] * rs[ai][m];
                        float q = (v0[0] * v0[0] + v0[1] * v0[1]) + (v0[2] * v0[2] + v0[3] * v0[3]) + (v1[0] * v1[0] + v1[1] * v1[1]) + (v1[2] * v1[2] + v1[3] * v1[3]);
                        q += __shfl_xor(q, 16); q += __shfl_xor(q, 32);
                        if (fq == 0) hnb[((wr * 128 + ai * 64 + m * 16 + fr) * 2 + bj) * 4 + wc] = q;
                    }
            asm volatile("s_waitcnt lgkmcnt(0)" ::: "memory"); __builtin_amdgcn_s_barrier(); asm volatile("" ::: "memory");
        }
#pragma unroll
        for (int ai = 0; ai < 2; ++ai)
#pragma unroll
            for (int m = 0; m < 4; ++m) {
                const int r = ai * 128 + wr * 64 + m * 16 + fr;
#pragma unroll
                for (int bj = 0; bj < 2; ++bj) {
                    float sc = rs[ai][m];
                    if (hn) { const f32x4 p = *(const LAS f32x4*)(hnb + ((wr * 128 + ai * 64 + m * 16 + fr) * 2 + bj) * 4); sc *= 1.0f / sqrtf(((p[0] + p[1]) + (p[2] + p[3])) * (1.0f / 128.0f) + EPS); }
                    const f32x4 v0 = acc[ai][bj][m][0] * sc * g0, v1 = acc[ai][bj][m][1] * sc * g1;
                    u32x4 w; w.x = cvtpk(v0[0], v0[1]); w.y = cvtpk(v0[2], v0[3]); w.z = cvtpk(v1[0], v1[1]); w.w = cvtpk(v1[2], v1[3]);
                    *(u32x4*)(O + (size_t)(u.pm * 256 + r) * ldo + col0 + bj * 128) = w;
                }
            }
    }
};

struct EpiTr {
    static constexpr bool PERM = true;
    RstdTab rt; bf16* O; int ldo;
    template <class Sched> __device__ __forceinline__ void prep_all(const Sched& S, int tid) const { rt.prep_all(S, tid); }
    __device__ __forceinline__ void operator()(const f32x4 (&acc)[2][2][4][2], const pg8::Unit& u, int ui, int wr, int wc, int fr_, int fq_) const {
        int fr = fr_, fq = fq_; asm volatile("" : "+v"(fr), "+v"(fq));
        const LAS float* tb = rt.tab + ui * 256;
        const int cb = wc * 32 + 8 * fq;
        f32x4 rc[2][2];
#pragma unroll
        for (int bj = 0; bj < 2; ++bj)
#pragma unroll
            for (int n = 0; n < 2; ++n) rc[bj][n] = *(const LAS f32x4*)(tb + bj * 128 + cb + 4 * n);
#pragma unroll
        for (int ai = 0; ai < 2; ++ai)
#pragma unroll
            for (int m = 0; m < 4; ++m) {
                const size_t row = (size_t)(u.pm * 256 + ai * 128 + wr * 64 + m * 16 + fr);
#pragma unroll
                for (int bj = 0; bj < 2; ++bj) {
                    const f32x4 v0 = acc[ai][bj][m][0] * rc[bj][0], v1 = acc[ai][bj][m][1] * rc[bj][1];
                    u32x4 w; w.x = cvtpk(v0[0], v0[1]); w.y = cvtpk(v0[2], v0[3]); w.z = cvtpk(v1[0], v1[1]); w.w = cvtpk(v1[2], v1[3]);
                    *(u32x4*)(O + row * ldo + u.pn * 256 + bj * 128 + cb) = w;
                }
            }
    }
};


#define XB_TMO      128
#define XB_XCNT(j)  (256  + 64 * (j))
#define XB_XSUB(j)  (1280 + 64 * (j))
#define XB_XGEN(j)  (2304 + 64 * (j))
#define XB_TOP      3328
#define XB_TOPGEN   3392
#define XCD_BAR_WORDS 3456
#define XB_SPIN_CAP (1u << 18)

__device__ __forceinline__ unsigned xb_ld(unsigned* p)              { return __hip_atomic_load(p, __ATOMIC_RELAXED, __HIP_MEMORY_SCOPE_AGENT); }
__device__ __forceinline__ unsigned xb_add(unsigned* p, unsigned v) { return __hip_atomic_fetch_add(p, v, __ATOMIC_RELAXED, __HIP_MEMORY_SCOPE_AGENT); }
__device__ __forceinline__ unsigned xb_xcc_id() { return (unsigned)__builtin_amdgcn_s_getreg((3 << 11) | 20) & 0xFu; }
#define XB_SPIN(cond, bar) do { unsigned _sp = 0; while (cond) { __builtin_amdgcn_s_sleep(1); \
    if ((++_sp & 255u) == 0u) { if (xb_ld(&(bar)[XB_TMO])) break; if (_sp > XB_SPIN_CAP) { atomicAdd(&(bar)[XB_TMO], 1u); break; } } } } while (0)

struct XcdBarrier { unsigned* bar; unsigned x; volatile LAS unsigned* st; };
__device__ __forceinline__ XcdBarrier xcd_barrier_post(unsigned* bar, volatile LAS unsigned* st, int tid) {
    XcdBarrier b; b.bar = bar; b.x = xb_xcc_id(); b.st = st;
    if (tid == 0) (void)xb_add(&bar[XB_XCNT(b.x)], 1u);
    return b;
}
__device__ __forceinline__ void xcd_barrier_complete(unsigned* bar, unsigned x, unsigned& nloc, unsigned& nx) {
    const unsigned G = gridDim.x * gridDim.y * gridDim.z;
    unsigned sum, cnt, mine, sp = 0u;
    for (;;) {
        sum = 0u; cnt = 0u; mine = 0u;
#pragma unroll
        for (unsigned j = 0; j < 16; ++j) { const unsigned c = xb_ld(&bar[XB_XCNT(j)]); sum += c; cnt += (c > 0u) ? 1u : 0u; mine = (j == x) ? c : mine; }
        if (sum == G) break;
        __builtin_amdgcn_s_sleep(1);
        if ((++sp & 255u) == 0u) { if (xb_ld(&bar[XB_TMO])) break; if (sp > XB_SPIN_CAP) { atomicAdd(&bar[XB_TMO], 1u); break; } }
    }
    nloc = mine > 0u ? mine : 1u; nx = cnt > 0u ? cnt : 1u;
}
__device__ __forceinline__ void xcd_barrier(const XcdBarrier& b, int tid) {
    asm volatile("s_waitcnt vmcnt(0)" ::: "memory");
    __syncthreads();
    if (tid == 0) {
        unsigned* bar = b.bar;
        __builtin_amdgcn_s_waitcnt(0);
        unsigned nloc = b.st[0], nx = b.st[1];
        if (nloc == 0u) { xcd_barrier_complete(bar, b.x, nloc, nx); b.st[0] = nloc; b.st[1] = nx; }
        const unsigned old = xb_add(&bar[XB_XSUB(b.x)], 1u);
        const unsigned gen = old / nloc;
        if (old + 1u == (gen + 1u) * nloc) {
            __builtin_amdgcn_fence(__ATOMIC_RELEASE, "agent");
            asm volatile("s_waitcnt vmcnt(0)" ::: "memory");
            const unsigned og = xb_add(&bar[XB_TOP], 1u);
            const unsigned tg = og / nx;
            if (og + 1u == (tg + 1u) * nx) xb_add(&bar[XB_TOPGEN], 1u);
            else XB_SPIN(xb_ld(&bar[XB_TOPGEN]) == tg, bar);
            __builtin_amdgcn_fence(__ATOMIC_ACQUIRE, "agent");
            xb_add(&bar[XB_XGEN(b.x)], 1u);
            asm volatile("s_waitcnt vmcnt(0)" ::: "memory");
        } else {
            XB_SPIN(xb_ld(&bar[XB_XGEN(b.x)]) == gen, bar);
            __builtin_amdgcn_fence(__ATOMIC_ACQUIRE, "agent");
            asm volatile("s_waitcnt vmcnt(0)" ::: "memory");
        }
    }
    __syncthreads();
}

#ifndef TIER_FFN
#define TIER_FFN 1
#endif
#ifndef TIER_MLSTM
#define TIER_MLSTM 1
#endif
#ifndef TIER_SB
#define TIER_SB 1
#endif
#ifndef TIER_PLE
#define TIER_PLE 1
#endif
#ifndef F_PER_PHASE
#define F_PER_PHASE 0
#endif
struct WsMap { size_t lo, ctl, wgu, wd, wmt, wmr, wmg, wmo, wk, wv, wq, wo, wpg, wpe, hb, ss, pb, pj, kvk, kvv, gates, chs, mprev, scratch; };
constexpr size_t SC_HID = 0, SC_TOK = 0, SC_TR = (size_t)M * 4096 * 2, SC_U = SC_TR + (size_t)2048 * M * 2, SC_CST = SC_U + (size_t)256 * 520 * 256 * 2, SC_END = SC_CST + (size_t)256 * 528 * 256 * 2;
constexpr size_t SC_HS = SC_U, SC_Q = 0, SC_OATT = (size_t)M * D * 2;
constexpr size_t WGU_SZ = (size_t)2 * DFF * D * 2, WD_SZ = (size_t)D * DFF * 2, WDD_SZ = (size_t)D * D * 2, WMT_SZ = (size_t)4096 * D * 2, WMR_SZ = (size_t)2048 * D * 2, WMG_SZ = 8 * D * 4, WPE_SZ = (size_t)D * DPLE * 2;
constexpr size_t HB_SZ = (size_t)M * D * 2, SS_SZ = (size_t)M * 32 * 4, PB_SZ = (size_t)M * DPLE * 2;
constexpr size_t CTL_BYTES = 1u << 20;
constexpr size_t align_up(size_t x) { return (x + 255) & ~(size_t)255; }
constexpr size_t max_sz(size_t a, size_t b) { return a > b ? a : b; }
struct HostPlan { WsMap m; size_t s_hn, s_t, s_kv, total; };
constexpr HostPlan make_plan() {
    HostPlan p{}; size_t o = 0;
#define TAKE(dst, bytes) do { dst = o; o = align_up(o + (bytes)); } while (0)
    const bool anyF = TIER_FFN || TIER_MLSTM || TIER_SB || TIER_PLE;
    TAKE(p.m.ctl, CTL_BYTES);
    if (TIER_FFN) { TAKE(p.m.wgu, 8 * WGU_SZ); TAKE(p.m.wd, 8 * WD_SZ); }
    if (TIER_MLSTM) { TAKE(p.m.wmt, 2 * WMT_SZ); TAKE(p.m.wmr, 2 * WMR_SZ); TAKE(p.m.wmg, 2 * WMG_SZ); TAKE(p.m.wmo, 2 * WDD_SZ); TAKE(p.m.gates, (size_t)M * 8 * 4); TAKE(p.m.chs, 4096); TAKE(p.m.mprev, 4096); }
    if (TIER_SB) { TAKE(p.m.wk, WDD_SZ); TAKE(p.m.wv, WDD_SZ); TAKE(p.m.wq, 2 * WDD_SZ); TAKE(p.m.wo, 2 * WDD_SZ); TAKE(p.m.kvk, HB_SZ); TAKE(p.m.kvv, HB_SZ); }
    if (TIER_PLE) { TAKE(p.m.wpg, 4 * WDD_SZ); TAKE(p.m.wpe, 4 * WPE_SZ); TAKE(p.m.pb, 4 * PB_SZ); TAKE(p.m.pj, HB_SZ); }
    if (anyF) { TAKE(p.m.hb, 2 * HB_SZ); TAKE(p.m.ss, 2 * SS_SZ); if (RESID_LO) TAKE(p.m.lo, HB_SZ); }
    size_t scr = 0;
    if (TIER_FFN) scr = max_sz(scr, (size_t)M * DFF * 2);
    if (TIER_MLSTM) scr = max_sz(scr, SC_END);
    if (TIER_SB) scr = max_sz(scr, 2 * HB_SZ);
    const bool anyS = !(TIER_FFN && TIER_MLSTM && TIER_SB && TIER_PLE);
    if (anyS) scr = max_sz(scr, align_up(S_HN_BYTES) + align_up(S_T_BYTES));
    TAKE(p.m.scratch, scr);
    p.s_hn = p.m.scratch; p.s_t = p.m.scratch + align_up(S_HN_BYTES);
    if (!TIER_SB) TAKE(p.s_kv, S_KV_BYTES);
    p.total = o;
#undef TAKE
    return p;
}
constexpr HostPlan PLAN = make_plan();
constexpr size_t WS_CTL = PLAN.m.ctl, WS_WGU = PLAN.m.wgu, WS_WD = PLAN.m.wd, WS_WMT = PLAN.m.wmt, WS_WMR = PLAN.m.wmr, WS_WMG = PLAN.m.wmg, WS_WMO = PLAN.m.wmo, WS_WK = PLAN.m.wk, WS_WV = PLAN.m.wv, WS_WQ = PLAN.m.wq, WS_WO = PLAN.m.wo,
                 WS_WPG = PLAN.m.wpg, WS_WPE = PLAN.m.wpe, WS_HB = PLAN.m.hb, WS_SS = PLAN.m.ss, WS_PB = PLAN.m.pb, WS_PJ = PLAN.m.pj, WS_KVK = PLAN.m.kvk, WS_KVV = PLAN.m.kvv, WS_GATES = PLAN.m.gates, WS_CHS = PLAN.m.chs, WS_MPREV = PLAN.m.mprev,
                 WS_SCRATCH = PLAN.m.scratch, WS_LO = PLAN.m.lo, WS_GQ = PLAN.m.ctl + CTL_BYTES - 4096;
constexpr int CW_BAR = 4096;
constexpr int PID_PRO = 0, PID_S0 = 8, PID_KVONLY = PID_S0 + 16 * 8, PID_END = PID_KVONLY + 8;
enum StageType { ST_FFN = 0, ST_MLSTM = 1, ST_SB = 2, ST_PLE = 3, ST_KVONLY = 4 };
__host__ __device__ inline int stage_type(int s) { if (s >= 16) return ST_KVONLY; const int layer = s >> 2, k = s & 3; return (k == 0 || k == 2) ? ST_FFN : (k == 3 ? ST_PLE : (layer < 2 ? ST_MLSTM : ST_SB)); }
#define PROJ_IN_FFN (TIER_FFN && TIER_PLE)
__host__ __device__ inline bool slot_active(int type, int slot) {
    if (slot == 0) return !(type == ST_PLE && PROJ_IN_FFN);
    if (type == ST_KVONLY) return false;
    if (slot == 4) return true;
    if (type == ST_MLSTM) return slot >= 1 && slot <= 3;
    if (type == ST_SB) return slot == 1;
    return false;
}
struct Args { const float* in[20]; float* out; unsigned char* ws; int ph_lo, ph_hi, ph_last, bar_region, cur_lo, kv_in_ffn, pad0, pad1; };
constexpr int INL_OFF = MISC_OFF + 256;
static_assert(INL_OFF + 256 <= LDS_BYTES, "LDS map");

struct Frame {
    LAS unsigned char* lds; int tid, lane, wave, G;
};
__device__ __forceinline__ const float* inptr(const Frame& F, int i) {
    u32x2 v; const unsigned addr = (unsigned)(size_t)(F.lds + INL_OFF) + 8u * (unsigned)i;
    asm volatile("ds_read_b64 %0, %1\n\ts_waitcnt lgkmcnt(0)" : "=&v"(v) : "v"(addr) : "memory");
    const unsigned long long p = ((unsigned long long)(unsigned)__builtin_amdgcn_readfirstlane((int)v.y) << 32) | (unsigned)__builtin_amdgcn_readfirstlane((int)v.x);
    return (const float*)(const GAS float*)p;
}
__device__ __forceinline__ float wave_max(float v) {
#pragma unroll
    for (int o = 1; o < 64; o <<= 1) v = fmaxf(v, __shfl_xor(v, o));
    return v;
}
template <int OP> __device__ __forceinline__ float block_scan256(float v, LAS float* scr, int tid) {
    const int lane = tid & 63, w = tid >> 6;
#pragma unroll
    for (int off = 1; off < 64; off <<= 1) { const float t = __shfl_up(v, off); if (lane >= off) v = OP ? fmaxf(v, t) : v + t; }
    __syncthreads();
    if (lane == 63 && w < 4) scr[w] = v;
    __syncthreads();
    if (w > 0 && w < 4) { float o = scr[0]; for (int i = 1; i < w; ++i) o = OP ? fmaxf(o, scr[i]) : o + scr[i]; v = OP ? fmaxf(v, o) : v + o; }
    return v;
}

struct ConvDesc { const float* W; const float* gain; bf16* dst; int ldw, col0, nblk, K, drow0, il, item; float cs; };
__device__ __forceinline__ void conv_item(const ConvDesc& d, LAS float* scr, int lane) {
    const int kb = d.item / d.nblk, nb = d.item % d.nblk, k0 = 64 * kb, n0 = 64 * nb;
    const int r = lane >> 4, c4 = lane & 15;
    f32x4 v[16]; float gs[16];
    const float* wp = d.W + (size_t)(k0 + r) * d.ldw + d.col0 + n0 + 4 * c4;
#pragma unroll
    for (int i = 0; i < 16; ++i) v[i] = *(const f32x4*)(wp + (size_t)(4 * i) * d.ldw);
#pragma unroll
    for (int i = 0; i < 16; ++i) gs[i] = d.gain ? d.gain[k0 + 4 * i + r] * d.cs : d.cs;
#pragma unroll
    for (int i = 0; i < 16; ++i) { const int k = 4 * i + r; *(LAS f32x4*)(scr + k * 64 + ((c4 ^ ((k >> 3) & 7)) * 4)) = v[i] * gs[i]; }
    LDS_WAIT(); asm volatile("" ::: "memory");
    const int c = lane & 7;
    const int dr0 = d.il ? (256 * (n0 >> 7) + 128 * (d.il - 1) + (n0 & 127)) : (d.drow0 + n0);
#pragma unroll
    for (int jj = 0; jj < 8; ++jj) { const int n = (lane >> 3) + 8 * jj; const LAS float* s = scr + (8 * c) * 64 + (((n >> 2) ^ c) * 4) + (n & 3);
        u32x4 o; o.x = cvtpk(s[0 * 64], s[1 * 64]); o.y = cvtpk(s[2 * 64], s[3 * 64]); o.z = cvtpk(s[4 * 64], s[5 * 64]); o.w = cvtpk(s[6 * 64], s[7 * 64]);
        *(u32x4*)(d.dst + (size_t)(dr0 + n) * d.K + k0 + 8 * c) = o; }
    LDS_WAIT(); asm volatile("" ::: "memory");
}
constexpr int CV_FFN1 = (D / 64) * (DFF / 64), CV_FFN = 8 * 3 * CV_FFN1, CV_ML1 = 4096, CV_ML = 2 * CV_ML1, CV_KV = 2048, CV_SB = 4096, CV_PLE1 = 1152, CV_PLE = 4 * CV_PLE1, CV_TOTAL = CV_FFN + CV_ML + CV_KV + CV_SB + CV_PLE;
__device__ __forceinline__ ConvDesc conv_decode(const Frame& F, unsigned char* ws, int it) {
    ConvDesc d; d.W = nullptr; d.gain = nullptr; d.dst = nullptr; d.ldw = D; d.col0 = 0; d.nblk = D / 64; d.K = D; d.drow0 = 0; d.il = 0; d.item = 0; d.cs = 1.f;
    if (it < CV_FFN) {
        if (!TIER_FFN) return d;
        const int wi = it / (3 * CV_FFN1), r = it % (3 * CV_FFN1), mat = r / CV_FFN1; d.item = r % CV_FFN1;
        if (mat < 2) { d.W = inptr(F, 3 + mat) + (size_t)wi * D * DFF; d.ldw = DFF; d.nblk = DFF / 64; d.dst = (bf16*)(ws + WS_WGU + (size_t)wi * WGU_SZ); d.il = 1 + mat; d.gain = inptr(F, 2) + wi * D; }
        else { d.W = inptr(F, 5) + (size_t)wi * DFF * D; d.K = DFF; d.dst = (bf16*)(ws + WS_WD + (size_t)wi * WD_SZ); }
        return d;
    }
    it -= CV_FFN;
    if (it < CV_ML) {
        if (!TIER_MLSTM) return d;
        const int l = it / CV_ML1, r = it % CV_ML1; d.W = inptr(F, 7) + (size_t)l * D * MPROJ; d.ldw = MPROJ; d.gain = inptr(F, 6) + l * D;
        bf16* mt = (bf16*)(ws + WS_WMT + (size_t)l * WMT_SZ); bf16* mr = (bf16*)(ws + WS_WMR + (size_t)l * WMR_SZ);
        if (r < 512) { d.nblk = 16; d.dst = mt; d.cs = 0.0625f; d.item = r; }
        else if (r < 1024) { d.col0 = 1024; d.nblk = 16; d.dst = mt; d.drow0 = 1024; d.item = r - 512; }
        else if (r < 2048) { d.col0 = 4096; d.dst = mt; d.drow0 = 2048; d.item = r - 1024; }
        else if (r < 3072) { d.col0 = 2048; d.dst = mr; d.item = r - 2048; }
        else { d.W = inptr(F, 10) + (size_t)l * D * D; d.ldw = D; d.gain = nullptr; d.dst = (bf16*)(ws + WS_WMO + (size_t)l * WDD_SZ); d.item = r - 3072; }
        return d;
    }
    it -= CV_ML;
    if (it < CV_KV) {
        if (!TIER_SB) return d;
        d.W = inptr(F, 12); d.ldw = 4096; d.gain = inptr(F, 11);
        if (it < 1024) { d.dst = (bf16*)(ws + WS_WK); d.item = it; } else { d.col0 = 2048; d.dst = (bf16*)(ws + WS_WV); d.item = it - 1024; }
        return d;
    }
    it -= CV_KV;
    if (it < CV_SB) {
        if (!TIER_SB) return d;
        const int j = it / 2048, r = it % 2048;
        if (r < 1024) { d.W = inptr(F, 14) + (size_t)j * D * D; d.gain = inptr(F, 6) + (2 + j) * D; d.dst = (bf16*)(ws + WS_WQ + (size_t)j * WDD_SZ); d.item = r; }
        else { d.W = inptr(F, 16) + (size_t)j * D * D; d.dst = (bf16*)(ws + WS_WO + (size_t)j * WDD_SZ); d.item = r - 1024; }
        return d;
    }
    it -= CV_SB;
    if (!TIER_PLE) return d;
    { const int l = it / CV_PLE1, r = it % CV_PLE1;
      if (r < 1024) { d.W = inptr(F, 19) + (size_t)l * D * D; d.gain = inptr(F, 17) + l * D; d.dst = (bf16*)(ws + WS_WPG + (size_t)l * WDD_SZ); d.item = r; }
      else { d.W = inptr(F, 18) + (size_t)l * DPLE * D; d.K = DPLE; d.dst = (bf16*)(ws + WS_WPE + (size_t)l * WPE_SZ); d.item = r - 1024; } }
    return d;
}
__device__ __forceinline__ void p_prologue(const Frame& F, unsigned char* ws) {
    LAS float* scr = (LAS float*)(F.lds + F.wave * 16384);
    const int gw = blockIdx.x * NWAVES + F.wave, NGW = F.G * NWAVES;
#pragma unroll 1
    for (int it = gw; it < CV_TOTAL; it += NGW) { const ConvDesc d = conv_decode(F, ws, it); if (d.W != nullptr) conv_item(d, scr, F.lane); }
    if (TIER_MLSTM) for (int l = 0; l < 2; ++l) {
        const float* win = inptr(F, 7) + (size_t)l * D * MPROJ; const float* g = inptr(F, 6) + l * D; float* wg = (float*)(ws + WS_WMG + (size_t)l * WMG_SZ);
        for (int i = blockIdx.x * 512 + F.tid; i < 8 * D; i += F.G * 512) { const int gi = i / D, k = i % D; wg[i] = win[(size_t)k * MPROJ + 6144 + gi] * g[k]; }
    }
    if (TIER_PLE) { const f32x4* src = (const f32x4*)inptr(F, 1); u32x4* dst = (u32x4*)(ws + WS_PB); const size_t n8 = (size_t)DEPTH * M * DPLE / 8;
      for (size_t i = (size_t)blockIdx.x * 512 + F.tid; i < n8; i += (size_t)F.G * 512) { const f32x4 v0 = src[2 * i], v1 = src[2 * i + 1];
          u32x4 w; w.x = cvtpk(v0[0], v0[1]); w.y = cvtpk(v0[2], v0[3]); w.z = cvtpk(v1[0], v1[1]); w.w = cvtpk(v1[2], v1[3]); dst[i] = w; } }
}
__device__ __forceinline__ void sync_rows(const float* src, bf16* hi, bf16* lo, float* ss, int gw, int NGW, int lane) {
    for (int row = gw; row < M; row += NGW) {
        const f32x4* xr = (const f32x4*)(src + (size_t)row * D); f32x4 v[8]; float s = 0.f;
#pragma unroll
        for (int j = 0; j < 4; ++j) { v[2 * j] = xr[2 * lane + 128 * j]; v[2 * j + 1] = xr[2 * lane + 128 * j + 1]; }
#pragma unroll
        for (int j = 0; j < 8; ++j) s += (v[j][0] * v[j][0] + v[j][1] * v[j][1]) + (v[j][2] * v[j][2] + v[j][3] * v[j][3]);
        s = wave_sum(s);
        u32x4* br = (u32x4*)(hi + (size_t)row * D); u32x4* lr = (u32x4*)(lo + (size_t)row * D);
#pragma unroll
        for (int j = 0; j < 4; ++j) { const f32x4 a0 = v[2 * j], a1 = v[2 * j + 1];
            u32x4 w; w.x = cvtpk(a0[0], a0[1]); w.y = cvtpk(a0[2], a0[3]); w.z = cvtpk(a1[0], a1[1]); w.w = cvtpk(a1[2], a1[3]);
            u32x4 l; l.x = cvtpk(a0[0] - bf_lo(w.x), a0[1] - bf_hi(w.x)); l.y = cvtpk(a0[2] - bf_lo(w.y), a0[3] - bf_hi(w.y)); l.z = cvtpk(a1[0] - bf_lo(w.z), a1[1] - bf_hi(w.z)); l.w = cvtpk(a1[2] - bf_lo(w.w), a1[3] - bf_hi(w.w));
            br[lane + 64 * j] = w; if (RESID_LO) lr[lane + 64 * j] = l; }
        if (lane < 32) ss[(size_t)row * 32 + lane] = (lane == 0) ? s : 0.f;
    }
}
__global__ __launch_bounds__(256) void k_f_sync(const float* h, bf16* hb, bf16* lo, float* ss) {
    sync_rows(h, hb, lo, ss, blockIdx.x * 4 + (threadIdx.x >> 6), gridDim.x * 4, threadIdx.x & 63);
}

__device__ __forceinline__ float logsigmoid_hw(float x) { const float e = __expf(-fabsf(x)), w = 1.0f + e; const float l = (w == 1.0f) ? e : __logf(w) * (e / (w - 1.0f)); return fminf(x, 0.f) - l; }
__device__ __forceinline__ void p_gates(const Frame& F, const bf16* hb, const float* ss, const float* wg, const float* bif, float* gates) {
    LAS float* W = (LAS float*)F.lds;
    __syncthreads();
    for (int i = F.tid; i < 8 * D / 4; i += NWAVES * 64) ((LAS f32x4*)W)[i] = ((const f32x4*)wg)[i];
    __syncthreads();
    const int gw = blockIdx.x * NWAVES + F.wave, NGW = F.G * NWAVES, lane = F.lane;
    for (int row = gw; row < M; row += 2 * NGW) {
        const int row1 = (row + NGW < M) ? row + NGW : row;
        float sq0 = (lane < 32) ? ss[(size_t)row * 32 + lane] : 0.f, sq1 = (lane < 32) ? ss[(size_t)row1 * 32 + lane] : 0.f;
        u32x2 h0[8], h1[8];
#pragma unroll
        for (int j = 0; j < 8; ++j) { h0[j] = *(const u32x2*)(hb + (size_t)row * D + 4 * lane + 256 * j); h1[j] = *(const u32x2*)(hb + (size_t)row1 * D + 4 * lane + 256 * j); }
        sq0 = wave_sum(sq0); sq1 = wave_sum(sq1);
        float a0[8], a1[8];
#pragma unroll
        for (int g = 0; g < 8; ++g) { a0[g] = 0.f; a1[g] = 0.f; }
#pragma unroll
        for (int j = 0; j < 8; ++j) {
            const float x0 = bf_lo(h0[j].x), x1 = bf_hi(h0[j].x), x2 = bf_lo(h0[j].y), x3 = bf_hi(h0[j].y);
            const float y0 = bf_lo(h1[j].x), y1 = bf_hi(h1[j].x), y2 = bf_lo(h1[j].y), y3 = bf_hi(h1[j].y);
#pragma unroll
            for (int g = 0; g < 8; ++g) { const f32x4 w = *(const LAS f32x4*)(W + g * D + 4 * lane + 256 * j);
                a0[g] += (x0 * w[0] + x1 * w[1]) + (x2 * w[2] + x3 * w[3]); a1[g] += (y0 * w[0] + y1 * w[1]) + (y2 * w[2] + y3 * w[3]); }
            asm volatile("" ::: "memory");
        }
        float mine = 0.f;
#pragma unroll
        for (int g = 0; g < 8; ++g) { const float t0 = wave_sum(a0[g]), t1 = wave_sum(a1[g]); if (lane == g) mine = t0; if (lane == 8 + g) mine = t1; }
        if (lane < 16 && (lane < 8 || row1 != row)) { const int gi = lane & 7; const int r = (lane < 8) ? row : row1; const float sq = (lane < 8) ? sq0 : sq1;
            const float pre = mine * (1.0f / sqrtf(sq * (1.0f / D) + EPS)) + bif[gi]; gates[(size_t)r * 8 + gi] = (gi < 4) ? pre : logsigmoid_hw(pre); }
    }
}


typedef float f32x16_t __attribute__((ext_vector_type(16)));
#define MFMA32(a, b, c) __builtin_amdgcn_mfma_f32_32x32x16_bf16((a), (b), (c), 0, 0, 0)
#define MFMA16(a, b, c) __builtin_amdgcn_mfma_f32_16x16x32_bf16((a), (b), (c), 0, 0, 0)

typedef short v4i16_t __attribute__((ext_vector_type(4)));
__device__ __forceinline__ unsigned offb(unsigned row, unsigned ch) { return 256u * row + 16u * (ch ^ (((row & 3u) << 2) | ((row >> 2) & 3u))); }
__device__ __forceinline__ void p_mlstm_a(const Frame& F, const float* gates, const bf16* tok, const bf16* vT, bf16* U, float* chs) {
    LAS unsigned char* L = F.lds;
    LAS float* wtab = (LAS float*)(L + TAB_OFF); LAS float* scr = wtab + 256;
    const int wave = F.wave;
    for (int u = blockIdx.x; u < 256; u += F.G) {
        int lane = F.lane; asm volatile("" : "+v"(lane));
        const int tid = wave * 64 + lane, hq = lane >> 5, l31 = lane & 31;
        const int bh = u >> 5, c = u & 31, b = bh >> 2, h = bh & 3;
        const size_t mbase = (size_t)b * SEQ + (size_t)c * 256;
        float li = 0.f, lf = 0.f;
        if (tid < 256) { li = gates[(mbase + tid) * 8 + h]; lf = gates[(mbase + tid) * 8 + 4 + h]; }
        { const bf16* src = tok + mbase * 4096 + 1024 + h * 256; u32x4 v[16];
          const unsigned goff = (unsigned)((tid >> 5) * 4096 + (tid & 31) * 8);
          const unsigned loff = (unsigned)(((tid & 31) >> 4) * 65536) + offb((unsigned)(tid >> 5), (unsigned)(tid & 15));
#pragma unroll
          for (int i = 0; i < 16; ++i) v[i] = *(const u32x4*)(src + (size_t)i * (16 * 4096) + goff);
#pragma unroll
          for (int i = 0; i < 16; ++i) *(LAS u32x4*)(L + i * (16 * 256) + loff) = v[i]; }
        const float bc = block_scan256<0>(lf, scr, tid);
        const float gt = li - bc;
        const float mxw = wave_max(tid < 256 ? gt : -3.0e38f);
        __syncthreads(); if (lane == 0) scr[8 + wave] = mxw; __syncthreads();
        const float cm = fmaxf(fmaxf(scr[8], scr[9]), fmaxf(scr[10], scr[11]));
        if (tid < 256) wtab[tid] = __expf(gt - cm);
        if (tid == 255) { chs[(bh * 32 + c) * 2] = bc; chs[(bh * 32 + c) * 2 + 1] = cm; }
        __syncthreads();
        bf16* Ub = U + (size_t)(bh * 32 + c) * 520 * 256;
        const unsigned blk = (lane >> 4) & 1, q = (lane & 15) >> 2, p = lane & 3;
#pragma unroll 1
        for (int i = 0; i < 2; ++i) {
            const int task = wave + 8 * i, eb = task >> 1, dh = task & 1;
            f32x16_t acc[2][4];
#pragma unroll
            for (int et = 0; et < 2; ++et)
#pragma unroll
                for (int dt = 0; dt < 4; ++dt)
#pragma unroll
                    for (int r = 0; r < 16; ++r) acc[et][dt][r] = 0.f;
            const bf16* vrow = vT + (size_t)(h * 512 + eb * 64 + l31) * M + mbase + 8 * hq;
            LAS unsigned char* img = L + dh * 65536;
#pragma unroll 1
            for (int kg = 0; kg < 4; ++kg) {
                u32x4 vb[8];
#pragma unroll
                for (int j = 0; j < 4; ++j)
#pragma unroll
                    for (int et = 0; et < 2; ++et) vb[2 * j + et] = *(const u32x4*)(vrow + (size_t)et * 32 * M + 16 * (4 * kg + j));
#pragma unroll
                for (int j = 0; j < 8; ++j) asm volatile("" : "+v"(vb[j]) :: "memory");
#pragma unroll
                for (int j = 0; j < 4; ++j) {
                    const int ks = 4 * kg + j;
                    const f32x4 w0 = *(const LAS f32x4*)(wtab + 16 * ks + 8 * hq), w1 = *(const LAS f32x4*)(wtab + 16 * ks + 8 * hq + 4);
                    bf16x8 af[2], bfr[4];
#pragma unroll
                    for (int et = 0; et < 2; ++et) { u32x4 v = vb[2 * j + et];
                        v.x = cvtpk(bf_lo(v.x) * w0[0], bf_hi(v.x) * w0[1]); v.y = cvtpk(bf_lo(v.y) * w0[2], bf_hi(v.y) * w0[3]);
                        v.z = cvtpk(bf_lo(v.z) * w1[0], bf_hi(v.z) * w1[1]); v.w = cvtpk(bf_lo(v.w) * w1[2], bf_hi(v.w) * w1[3]); af[et] = __builtin_bit_cast(bf16x8, v); }
#pragma unroll
                    for (int dt = 0; dt < 4; ++dt) {
                        const unsigned r0 = 16u * ks + 8u * hq + q, ch = 4u * dt + 2u * blk + (p >> 1);
                        const s16x4 lo = __builtin_bit_cast(s16x4, __builtin_amdgcn_ds_read_tr16_b64_v4i16((LAS v4i16_t*)(img + offb(r0, ch) + 8u * (p & 1))));
                        const s16x4 hi = __builtin_bit_cast(s16x4, __builtin_amdgcn_ds_read_tr16_b64_v4i16((LAS v4i16_t*)(img + offb(r0 + 4u, ch) + 8u * (p & 1))));
                        bfr[dt] = __builtin_shufflevector(lo, hi, 0, 1, 2, 3, 4, 5, 6, 7);
                    }
#pragma unroll
                    for (int et = 0; et < 2; ++et)
#pragma unroll
                        for (int dt = 0; dt < 4; ++dt) acc[et][dt] = MFMA32(af[et], bfr[dt], acc[et][dt]);
                }
            }
#pragma unroll
            for (int et = 0; et < 2; ++et)
#pragma unroll
                for (int dt = 0; dt < 4; ++dt)
#pragma unroll
                    for (int r = 0; r < 16; ++r) { const int e = eb * 64 + et * 32 + (r & 3) + 8 * (r >> 2) + 4 * hq, d = dh * 128 + dt * 32 + l31; Ub[(size_t)e * 256 + d] = (bf16)(cvtpk(acc[et][dt][r], 0.f) & 0xffffu); }
        }
        if (tid < 256) {
            LAS unsigned char* img = L + (tid >> 7) * 65536; const unsigned col = (unsigned)tid & 127u; float s = 0.f;
#pragma unroll 4
            for (int ss = 0; ss < 256; ++ss) { const unsigned short kv = *(const LAS unsigned short*)(img + offb((unsigned)ss, col >> 3) + 2u * (col & 7u)); s += __uint_as_float(((unsigned)kv) << 16) * wtab[ss]; }
            Ub[(size_t)512 * 256 + tid] = (bf16)(cvtpk(s, 0.f) & 0xffffu); }
        __syncthreads();
    }
}
__device__ __forceinline__ void p_mlstm_b(const Frame& F, const bf16* U, const float* chs, bf16* cst, float* mprev) {
    const int ntask = 8 * 528 * 32;
    for (int task = blockIdx.x * 512 + F.tid; task < ntask; task += F.G * 512) {
        const int bh = task / (528 * 32), rem = task % (528 * 32), e = rem >> 5, d0 = (rem & 31) * 8;
        if (e > 512) { const u32x4 z = {0u, 0u, 0u, 0u}; for (int c = 0; c < 32; ++c) *(u32x4*)(cst + ((size_t)(bh * 32 + c) * 528 + e) * 256 + d0) = z; continue; }
        f32x4 s0 = {0.f, 0.f, 0.f, 0.f}, s1 = {0.f, 0.f, 0.f, 0.f}; float m = 0.f;
        for (int c = 0; c < 32; ++c) {
            const float bL = chs[(bh * 32 + c) * 2], cmL = chs[(bh * 32 + c) * 2 + 1];
            u32x4 w; w.x = cvtpk(s0[0], s0[1]); w.y = cvtpk(s0[2], s0[3]); w.z = cvtpk(s1[0], s1[1]); w.w = cvtpk(s1[2], s1[3]);
            *(u32x4*)(cst + ((size_t)(bh * 32 + c) * 528 + e) * 256 + d0) = w;
            if (e == 0 && d0 == 0) mprev[bh * 32 + c] = m;
            const float mn = bL + fmaxf(m, cmL), ad = __expf(m + bL - mn), sc = __expf(bL + cmL - mn);
            const u32x4 uw = *(const u32x4*)(U + ((size_t)(bh * 32 + c) * 520 + e) * 256 + d0);
            const f32x4 u0 = {bf_lo(uw.x), bf_hi(uw.x), bf_lo(uw.y), bf_hi(uw.y)}, u1 = {bf_lo(uw.z), bf_hi(uw.z), bf_lo(uw.w), bf_hi(uw.w)};
            s0 = s0 * ad + u0 * sc; s1 = s1 * ad + u1 * sc; m = mn;
        }
    }
}
__device__ __forceinline__ void p_mlstm_c(const Frame& F, const float* gates, const bf16* tok, const bf16* trb, const bf16* cst, const float* mprev, const float* ghead, bf16* hs) {
    LAS unsigned char* L = F.lds;
    LAS float* gtab = (LAS float*)(L + TAB_OFF); LAS float* Mtab = gtab + 256; LAS float* btab = gtab + 512; LAS float* ntab = gtab + 768; LAS float* scr = gtab + 1024; LAS float* ghtab = gtab + 1280;
    const int wave = F.wave;
    constexpr int KVBUF = 16384 + 32768, VOFF = 16384;
    for (int unit = blockIdx.x; unit < 512; unit += F.G) {
        int lane = F.lane; asm volatile("" : "+v"(lane));
        const int tid = wave * 64 + lane, g = lane >> 4, l15 = lane & 15;
        const int qh = unit >> 8, rest = unit & 255, bh = rest >> 5, c = rest & 31, b = bh >> 2, h = bh & 3;
        const size_t mbase = (size_t)b * SEQ + (size_t)c * 256;
        const bf16* cbase = cst + (size_t)(bh * 32 + c) * 528 * 256;
        float li = 0.f, lf = 0.f;
        if (tid < 256) { li = gates[(mbase + tid) * 8 + h]; lf = gates[(mbase + tid) * 8 + 4 + h]; }
        const float bc = block_scan256<0>(lf, scr, tid);
        const float gt = li - bc;
        const float cmx = block_scan256<1>(tid < 256 ? gt : -3.0e38f, scr, tid);
        const float me = mprev[bh * 32 + c];
        ghtab[tid] = ghead[h * 512 + tid];
        if (tid < 256) { gtab[tid] = gt; Mtab[tid] = fmaxf(me, cmx); btab[tid] = bc; ntab[tid] = __uint_as_float(((unsigned)cbase[512 * 256 + tid]) << 16); }
        __syncthreads();
        const int tl = 128 * qh + 16 * wave + l15;
        const float Mt = Mtab[tl];
        const bf16* qrow = tok + (mbase + tl) * 4096 + h * 256 + 8 * g;
        bf16x8 qf[8];
#pragma unroll
        for (int ks = 0; ks < 8; ++ks) qf[ks] = *(const bf16x8*)(qrow + 32 * ks);
        const int nkt = ((128 * qh + 16 * wave + 15) >> 5) + 1, ktmax = 4 * qh + 4;
        int cof[4];
#pragma unroll
        for (int j = 0; j < 4; ++j) cof[j] = 16 * (4 * (j ^ (l15 >> 2)) + (g ^ (l15 & 3)));
        f32x4 acc[32];
#pragma unroll
        for (int et = 0; et < 32; ++et) acc[et] = (f32x4){0.f, 0.f, 0.f, 0.f};
#pragma unroll
        for (int ps = 0; ps < 2; ++ps) {
            __syncthreads();
            { const char* srcb = (const char*)(cbase + (size_t)(256 * ps) * 256 + (size_t)(32 * wave) * 256); const int rr = lane >> 5, sl = lane & 31;
#pragma unroll
              for (int i = 0; i < 16; ++i) { const unsigned vo = (unsigned)(rr * 512 + ((sl ^ ((2 * i + rr) & 15)) * 16));
                  __builtin_amdgcn_global_load_lds((const unsigned*)(srcb + (size_t)(2 * i) * 512 + vo), (LAS unsigned*)(L + (32 * wave + 2 * i) * 512), 16, 0, 0); } }
            __syncthreads();
#pragma unroll
            for (int et = 0; et < 16; ++et) {
                bf16x8 fa[8];
#pragma unroll
                for (int ks = 0; ks < 8; ++ks) fa[ks] = *(const LAS bf16x8*)(L + (16 * et + l15) * 512 + cof[ks & 3] + 256 * (ks >> 2));
#pragma unroll
                for (int ks = 0; ks < 8; ++ks) asm volatile("" : "+v"(fa[ks]) :: "memory");
#pragma unroll
                for (int ks = 0; ks < 8; ++ks) acc[16 * ps + et] = MFMA16(fa[ks], qf[ks], acc[16 * ps + et]);
            }
        }
        { const float winter = __expf(me - Mt);
#pragma unroll
          for (int et = 0; et < 32; ++et) acc[et] *= winter; }
        float denp = 0.f;
        const bf16* ksrc = tok + mbase * 4096 + 1024 + h * 256;
        const bf16* vsrc = trb + (size_t)(h * 512) * M + mbase;
        const unsigned kvo0 = (unsigned)((lane >> 5) * 8192 + (((lane & 31) ^ ((((4 * wave + (lane >> 5)) >> 3) & 3) << 2 | ((lane >> 5) & 3))) * 16));
        const unsigned vvo = (unsigned)((lane >> 2) * (M * 2) + (((lane & 3) ^ ((lane >> 4) & 3)) * 16));
        const char* kub = (const char*)(ksrc + (size_t)(4 * wave) * 4096); const char* vub = (const char*)(vsrc + (size_t)(64 * wave) * M);
#define STAGE_DMA(kt_, buf_) do { \
            __builtin_amdgcn_global_load_lds((const unsigned*)(kub + (size_t)(32 * (kt_)) * 8192 + kvo0), (LAS unsigned*)(L + (buf_) * KVBUF + (4 * wave) * 512), 16, 0, 0); \
            __builtin_amdgcn_global_load_lds((const unsigned*)(kub + (size_t)(32 * (kt_) + 2) * 8192 + (kvo0 ^ 32u)), (LAS unsigned*)(L + (buf_) * KVBUF + (4 * wave + 2) * 512), 16, 0, 0); \
            _Pragma("unroll") for (int i = 0; i < 4; ++i) \
                __builtin_amdgcn_global_load_lds((const unsigned*)(vub + (size_t)(16 * i) * M * 2 + (size_t)(32 * (kt_)) * 2 + vvo), (LAS unsigned*)(L + (buf_) * KVBUF + VOFF + (64 * wave + 16 * i) * 64), 16, 0, 0); } while (0)
        __syncthreads();
        STAGE_DMA(0, 0);
        const int kr0 = 8 * (l15 >> 2) + (l15 & 3);
#pragma unroll 1
        for (int kt = 0; kt < ktmax; ++kt) {
            __syncthreads();
            if (kt + 1 < ktmax) STAGE_DMA(kt + 1, (kt + 1) & 1);
            if (kt < nkt) {
                LAS unsigned char* KB = L + (kt & 1) * KVBUF; LAS unsigned char* VB = KB + VOFF;
                f32x4 s0 = {0.f, 0.f, 0.f, 0.f}, s1 = {0.f, 0.f, 0.f, 0.f};
#pragma unroll
                for (int hh = 0; hh < 2; ++hh) {
                    bf16x8 fa[8];
#pragma unroll
                    for (int ks = 0; ks < 8; ++ks) fa[ks] = *(const LAS bf16x8*)(KB + (kr0 + 4 * hh) * 512 + cof[ks & 3] + 256 * (ks >> 2));
#pragma unroll
                    for (int ks = 0; ks < 8; ++ks) asm volatile("" : "+v"(fa[ks]) :: "memory");
#pragma unroll
                    for (int ks = 0; ks < 8; ++ks) { if (hh == 0) s0 = MFMA16(fa[ks], qf[ks], s0); else s1 = MFMA16(fa[ks], qf[ks], s1); }
                }
                const int k0 = 32 * kt + 8 * g;
                const f32x4 g0 = *(const LAS f32x4*)(gtab + k0), g1 = *(const LAS f32x4*)(gtab + k0 + 4);
                float p[8];
#pragma unroll
                for (int r = 0; r < 4; ++r) { p[r] = (k0 + r <= tl) ? s0[r] * __expf(g0[r] - Mt) : 0.f; p[4 + r] = (k0 + 4 + r <= tl) ? s1[r] * __expf(g1[r] - Mt) : 0.f; }
                denp += ((p[0] + p[1]) + (p[2] + p[3])) + ((p[4] + p[5]) + (p[6] + p[7]));
                u32x4 pw; pw.x = cvtpk(p[0], p[1]); pw.y = cvtpk(p[2], p[3]); pw.z = cvtpk(p[4], p[5]); pw.w = cvtpk(p[6], p[7]);
                const bf16x8 pf = __builtin_bit_cast(bf16x8, pw);
#pragma unroll
                for (int eg = 0; eg < 4; ++eg) {
                    bf16x8 fa[8];
#pragma unroll
                    for (int j = 0; j < 8; ++j) { const int e = 16 * (8 * eg + j) + l15; fa[j] = *(const LAS bf16x8*)(VB + e * 64 + ((g ^ ((e >> 2) & 3)) * 16)); }
#pragma unroll
                    for (int j = 0; j < 8; ++j) asm volatile("" : "+v"(fa[j]) :: "memory");
#pragma unroll
                    for (int j = 0; j < 8; ++j) acc[8 * eg + j] = MFMA16(fa[j], pf, acc[8 * eg + j]);
                }
            }
        }
#undef STAGE_DMA
        denp += __shfl_xor(denp, 16); denp += __shfl_xor(denp, 32);
        float dn = 0.f;
#pragma unroll
        for (int ks = 0; ks < 8; ++ks) { const u32x4 qw = __builtin_bit_cast(u32x4, qf[ks]); const f32x4 n0 = *(const LAS f32x4*)(ntab + 32 * ks + 8 * g), n1 = *(const LAS f32x4*)(ntab + 32 * ks + 8 * g + 4);
            dn += (bf_lo(qw.x) * n0[0] + bf_hi(qw.x) * n0[1]) + (bf_lo(qw.y) * n0[2] + bf_hi(qw.y) * n0[3]) + (bf_lo(qw.z) * n1[0] + bf_hi(qw.z) * n1[1]) + (bf_lo(qw.w) * n1[2] + bf_hi(qw.w) * n1[3]); if (ks & 1) asm volatile("" ::: "memory"); }
        dn += __shfl_xor(dn, 16); dn += __shfl_xor(dn, 32); dn *= __expf(me - Mt);
        int tl2 = tl; asm volatile("" : "+v"(tl2));
        const float mt = btab[tl2] + Mt;
        const float inv = 1.0f / fmaxf(fabsf(dn + denp), __expf(-mt));
        float sq = 0.f;
#pragma unroll
        for (int et = 0; et < 32; ++et) { acc[et] *= inv; sq += (acc[et][0] * acc[et][0] + acc[et][1] * acc[et][1]) + (acc[et][2] * acc[et][2] + acc[et][3] * acc[et][3]); }
        sq += __shfl_xor(sq, 16); sq += __shfl_xor(sq, 32);
        const float rn = 1.0f / sqrtf(sq * (1.0f / DV) + EPS);
        const bf16* ogr = tok + (mbase + tl2) * 4096 + 2048 + h * 512 + 4 * g; bf16* hr = hs + (mbase + tl2) * 2048 + h * 512 + 4 * g;
        u32x2 ov[32];
#pragma unroll
        for (int et = 0; et < 32; ++et) ov[et] = *(const u32x2*)(ogr + 16 * et);
#pragma unroll
        for (int et = 0; et < 32; ++et) asm volatile("" : "+v"(ov[et]) :: "memory");
#pragma unroll
        for (int et = 0; et < 32; ++et) {
            const f32x4 gh = *(const LAS f32x4*)(ghtab + 16 * et + 4 * g);
            const float o0 = acc[et][0] * rn * gh[0] * fast_sigmoid(bf_lo(ov[et].x)), o1 = acc[et][1] * rn * gh[1] * fast_sigmoid(bf_hi(ov[et].x)), o2 = acc[et][2] * rn * gh[2] * fast_sigmoid(bf_lo(ov[et].y)), o3 = acc[et][3] * rn * gh[3] * fast_sigmoid(bf_hi(ov[et].y));
            u32x2 w; w.x = cvtpk(o0, o1); w.y = cvtpk(o2, o3); *(u32x2*)(hr + 16 * et) = w; if ((et & 3) == 3) asm volatile("" ::: "memory"); }
        __syncthreads();
    }
}
__device__ __forceinline__ void p_sbattn(const Frame& F, const bf16* q, const bf16* kh, const bf16* vT, bf16* o, const int cap = 1 << 20) {
    const int wave = F.wave;
    LAS unsigned char* WL = F.lds + wave * 16384;
    for (int unit = blockIdx.x; unit < 1024; unit += F.G) {
        int lane = F.lane; asm volatile("" : "+v"(lane));
        const int hq = lane >> 5, l31 = lane & 31, j4 = lane >> 4, p16 = lane & 15;
        const int b = unit >> 9, rem = unit & 511, hd = rem >> 5, qb = rem & 31;
        const int tb = qb * 256 + 32 * wave, t = tb + l31; const size_t rb = (size_t)b * SEQ;
        bf16x8 qf[8];
#pragma unroll
        for (int ks = 0; ks < 8; ++ks) qf[ks] = *(const bf16x8*)(q + (rb + t) * 2048 + hd * 128 + 16 * ks + 8 * hq);
        unsigned kq[4];
#pragma unroll
        for (int c = 0; c < 4; ++c) kq[c] = (unsigned)(j4 * 4096 + (((p16 ^ j4) ^ (4 * c)) * 16));
        const unsigned vq = (unsigned)((lane >> 2) * (M * 2) + ((((lane & 3) ^ ((lane >> 4) & 3))) * 16));
        const char* kub = (const char*)(kh + rb * 2048 + hd * 128); const char* vub = (const char*)(vT + (size_t)(hd * 128) * M + rb);
#define SB_STAGE(s_) do { \
            _Pragma("unroll") for (int i = 0; i < 8; ++i) __builtin_amdgcn_global_load_lds((const unsigned*)(kub + (size_t)((s_) + 16 * (i & 1) + 4 * (i >> 1)) * 4096 + kq[i & 3]), (LAS unsigned*)(WL + i * 1024), 16, 0, 0); \
            _Pragma("unroll") for (int i = 0; i < 8; ++i) __builtin_amdgcn_global_load_lds((const unsigned*)(vub + (size_t)(16 * i) * (M * 2) + (size_t)(s_) * 2 + vq), (LAS unsigned*)(WL + 8192 + i * 1024), 16, 0, 0); } while (0)
        f32x16_t oa[4];
#pragma unroll
        for (int dt = 0; dt < 4; ++dt)
#pragma unroll
            for (int r = 0; r < 16; ++r) oa[dt][r] = 0.f;
        float carry = 1.f;
        const unsigned kra = (unsigned)(l31 * 256), vra = (unsigned)(8192 + l31 * 64), sw16 = (unsigned)(l31 & 15), sw4 = (unsigned)((l31 >> 2) & 3);
        SB_STAGE(tb);
#pragma unroll 1
        for (int s0 = tb; ; s0 -= 32) {
            asm volatile("s_waitcnt vmcnt(0)" ::: "memory");
            bf16x8 kf[8], vf[8];
#pragma unroll
            for (int ks = 0; ks < 8; ++ks) kf[ks] = *(const LAS bf16x8*)(WL + kra + (((unsigned)(2 * ks + hq) ^ sw16) * 16));
#pragma unroll
            for (int sp = 0; sp < 2; ++sp)
#pragma unroll
                for (int dt = 0; dt < 4; ++dt) vf[4 * sp + dt] = *(const LAS bf16x8*)(WL + vra + dt * 2048 + (((unsigned)(2 * hq + sp) ^ sw4) * 16));
#pragma unroll
            for (int ks = 0; ks < 8; ++ks) asm volatile("" : "+v"(kf[ks]), "+v"(vf[ks]));
            asm volatile("s_waitcnt lgkmcnt(0)" ::: "memory");
            if (s0 >= 32) SB_STAGE(s0 - 32);
            f32x16_t z;
#pragma unroll
            for (int r = 0; r < 16; ++r) z[r] = 0.f;
#pragma unroll
            for (int ks = 0; ks < 8; ++ks) z = MFMA32(kf[ks], qf[ks], z);
            float a[16]; float P = 1.f; const int sbase = s0 + 16 * hq;
#pragma unroll
            for (int i = 15; i >= 0; --i) {
                const float zz = fminf(fmaxf(z[i], -80.f), 80.f), e = __expf(-zz), sg = __builtin_amdgcn_rcpf(1.0f + e);
                const bool valid = (sbase + i) < t;
                a[i] = valid ? sg * P : 0.f; P = valid ? P * (e * sg) : P;
            }
            const float Tp = __shfl_xor(P, 32);
            const float fac = carry * (hq == 0 ? Tp : 1.f);
            carry = carry * P * Tp;
#pragma unroll
            for (int sp = 0; sp < 2; ++sp) {
                u32x4 pw; pw.x = cvtpk(a[8 * sp] * fac, a[8 * sp + 1] * fac); pw.y = cvtpk(a[8 * sp + 2] * fac, a[8 * sp + 3] * fac); pw.z = cvtpk(a[8 * sp + 4] * fac, a[8 * sp + 5] * fac); pw.w = cvtpk(a[8 * sp + 6] * fac, a[8 * sp + 7] * fac);
                const bf16x8 pf = __builtin_bit_cast(bf16x8, pw);
#pragma unroll
                for (int dt = 0; dt < 4; ++dt) oa[dt] = MFMA32(vf[4 * sp + dt], pf, oa[dt]);
            }
            if (s0 < 32 || __all(carry == 0.f) || (tb - s0) >= 32 * (cap - 1)) break;
        }
#undef SB_STAGE
        asm volatile("s_waitcnt vmcnt(0)" ::: "memory");
#pragma unroll
        for (int dt = 0; dt < 4; ++dt)
#pragma unroll
            for (int gq = 0; gq < 4; ++gq) { u32x2 w; w.x = cvtpk(oa[dt][4 * gq], oa[dt][4 * gq + 1]); w.y = cvtpk(oa[dt][4 * gq + 2], oa[dt][4 * gq + 3]);
                *(LAS u32x2*)(WL + kra + (((unsigned)(4 * dt + gq) ^ sw16) * 16) + 8 * hq) = w; }
        asm volatile("s_waitcnt lgkmcnt(0)" ::: "memory");
        bf16* ob = o + (rb + tb) * 2048 + hd * 128;
#pragma unroll
        for (int i = 0; i < 8; ++i) { const int row = 4 * i + j4; const u32x4 w = *(const LAS u32x4*)(WL + i * 1024 + lane * 16);
            *(u32x4*)(ob + (size_t)row * 2048 + ((p16 ^ (row & 15)) * 8)) = w; }
        asm volatile("s_waitcnt lgkmcnt(0)" ::: "memory");
    }
}


#ifndef WGM_DN
#define WGM_DN 4
#endif
#ifndef WGM_RES
#define WGM_RES 4
#endif
#ifndef PROBE_REP
#define PROBE_REP 0
#endif
#ifndef PROBE_CAP
#define PROBE_CAP (1 << 20)
#endif
#ifndef PROBE_REP_N
#define PROBE_REP_N 4
#endif
#ifndef GEMM_ALIGN
#define GEMM_ALIGN true
#endif
#define GEMM_PHASE(EPI, g, S, E) pg8::gemm_phase<EPI, pg8::StaticOrder, GEMM_ALIGN, true>(P.lds, g, S, E, P.tid)
#define PHASE_BEGIN Frame P; P.lds = F.lds; P.G = F.G; P.wave = F.wave; { int l_; asm volatile("v_mbcnt_lo_u32_b32 %0, -1, 0\n\tv_mbcnt_hi_u32_b32 %0, -1, %0" : "=v"(l_)); P.lane = l_; P.tid = P.wave * 64 + l_; } \
    GAS unsigned char* wsg_ = (GAS unsigned char*)a.ws; asm volatile("" : "+s"(wsg_)); unsigned char* ws = (unsigned char*)wsg_; GAS float* outg_ = (GAS float*)a.out; asm volatile("" : "+s"(outg_)); float* outp = (float*)outg_; (void)outp; unsigned char* sc = ws + WS_SCRATCH; bf16* hb0 = (bf16*)(ws + WS_HB); float* ss0 = (float*)(ws + WS_SS); \
    const bf16* hb_in = hb0 + (size_t)cur * ((size_t)M * D); const float* ss_in = ss0 + (size_t)cur * ((size_t)M * 32); bf16* hb_out = hb0 + (size_t)(cur ^ 1) * ((size_t)M * D); float* ss_out = ss0 + (size_t)(cur ^ 1) * ((size_t)M * 32); \
    (void)sc; (void)hb_in; (void)ss_in; (void)hb_out; (void)ss_out
__global__ void __launch_bounds__(NWAVES * 64, 2) fwd(Args a) {
    extern __shared__ __attribute__((aligned(16))) unsigned char lds_raw[];
    Frame F; F.lds = (LAS unsigned char*)lds_raw; F.tid = threadIdx.x; F.lane = F.tid & 63; F.wave = __builtin_amdgcn_readfirstlane(F.tid >> 6); F.G = gridDim.x;
    volatile LAS unsigned* MISC = (volatile LAS unsigned*)(F.lds + MISC_OFF);
    if (F.tid < 64) MISC[F.tid] = 0u;
    if (F.tid < 20) ((LAS unsigned long long*)(F.lds + INL_OFF))[F.tid] = (unsigned long long)a.in[F.tid];
    __syncthreads();
    unsigned* ctl = (unsigned*)(a.ws + WS_CTL);
    const XcdBarrier bar = xcd_barrier_post(ctl + CW_BAR + a.bar_region * XCD_BAR_WORDS, MISC + 8, F.tid);
#define SEAM(pid) do { if ((pid) != a.ph_last) xcd_barrier(bar, P.tid); } while (0)
#define RUN(pid) (a.ph_lo <= (pid) && (pid) < a.ph_hi)
    LAS float* tab = (LAS float*)(F.lds + TAB_OFF); LAS float* hnb = (LAS float*)(F.lds + HNB_OFF);

    if (RUN(PID_PRO)) {
        const int cur = 0; PHASE_BEGIN;
        p_prologue(P, ws);
        sync_rows(inptr(P, 0), hb0, (bf16*)(ws + WS_LO), ss0, blockIdx.x * NWAVES + P.wave, P.G * NWAVES, P.lane);
        { const float* qn = inptr(P, 15); float* gq = (float*)(ws + WS_GQ); if (TIER_SB && blockIdx.x == 0 && P.tid < 256) gq[P.tid] = qn[P.tid] * 0.08838834764831845f; }
        SEAM(PID_PRO);
    }
    const int s_first = (a.ph_lo > PID_S0 ? a.ph_lo - PID_S0 : 0) >> 3;
    const int s_end = (a.ph_hi - PID_S0 + 7) >> 3;
#pragma unroll 1
    for (int s2 = (PROBE_REP == 5 ? 2 : 1) * s_first; s2 < (PROBE_REP == 5 ? 2 : 1) * s_end; ++s2) {
        const int s = (PROBE_REP == 5) ? (s2 >> 1) : s2;
        const int type = stage_type(s), layer = (s >> 2) & 3, k = s & 3, pid0 = PID_S0 + 8 * s;
        const int cur = (s >= 16) ? a.cur_lo : ((a.cur_lo + (s - s_first)) & 1);
        const int wi = layer * 2 + (k >> 1);
        if (RUN(pid0) && slot_active(type, 0)) {
            PHASE_BEGIN; float* gq = (float*)(ws + WS_GQ);
            const bool kv_here = (type == ST_KVONLY) || (type == ST_FFN && s == 8 && a.kv_in_ffn);
            if (type == ST_FFN) {
                pg8::Gemm g{hb_in, (const bf16*)(ws + WS_WGU + (size_t)wi * WGU_SZ), M, 2 * DFF, D}; pg8::StaticOrder S; S.init(M, 2 * DFF, P.G, (int)blockIdx.x);
                EpiGU E{RstdTab{ss_in, tab, 0}, (bf16*)(sc + SC_HID)};
                GEMM_PHASE(EpiGU, g, S, E);
            }
#pragma unroll 1
            for (int pass = 0; pass < 2; ++pass) {
                pg8::Gemm g{hb_in, nullptr, M, D, D}; EpiTok E{RstdTab{ss_in, tab, 0}, nullptr, D, nullptr, hnb, 0}; bool have = false; int tokG = P.G, tokC = (int)blockIdx.x;
                if (pass == 0) {
                    if (type == ST_MLSTM) { have = true; g.Bt = (const bf16*)(ws + WS_WMT + (size_t)layer * WMT_SZ); g.N = 4096; E.O = (bf16*)(sc + SC_TOK); E.ldo = 4096; }
                    else if (type == ST_SB) { have = true; g.Bt = (const bf16*)(ws + WS_WQ + (size_t)(layer - 2) * WDD_SZ); E.O = (bf16*)(sc + SC_Q); E.gain = gq + (layer - 2) * 128; E.hn = 1; }
                    else if (type == ST_PLE) { have = true; g.A = (const bf16*)(ws + WS_PB + (size_t)layer * PB_SZ); g.Bt = (const bf16*)(ws + WS_WPE + (size_t)layer * WPE_SZ); g.K = DPLE; E.rt.ss = nullptr; E.O = (bf16*)(ws + WS_PJ); }
                    else if (kv_here) { have = true; g.Bt = (const bf16*)(ws + WS_WK); E.O = (bf16*)(ws + WS_KVK); E.gain = inptr(P, 13); E.hn = 1; }
                } else if (PROJ_IN_FFN && type == ST_FFN) {
                    const size_t half = (size_t)(k >> 1) * (M / 2);
                    have = true; g.M = M / 2; g.A = (const bf16*)(ws + WS_PB + (size_t)layer * PB_SZ) + half * DPLE; g.Bt = (const bf16*)(ws + WS_WPE + (size_t)layer * WPE_SZ); g.K = DPLE; E.rt.ss = nullptr; E.O = (bf16*)(ws + WS_PJ) + half * D;
                    tokG = 64; tokC = ((int)blockIdx.x >= P.G - 64) ? (int)blockIdx.x - (P.G - 64) : (1 << 24);
                }
                if (have) { pg8::StaticOrder S; S.init(g.M, g.N, tokG, tokC); GEMM_PHASE(EpiTok, g, S, E); }
            }
            {
                pg8::Gemm g{nullptr, hb_in, 0, M, D}; EpiTr E{RstdTab{ss_in, tab, 1}, nullptr, M}; bool have = false;
                if (type == ST_MLSTM) { have = true; g.A = (const bf16*)(ws + WS_WMR + (size_t)layer * WMR_SZ); g.M = 2048; E.O = (bf16*)(sc + SC_TR); }
                else if (kv_here) { have = true; g.A = (const bf16*)(ws + WS_WV); g.M = D; E.O = (bf16*)(ws + WS_KVV); }
                if (have) { pg8::StaticOrder S; S.init(g.M, g.N, P.G, (int)blockIdx.x); GEMM_PHASE(EpiTr, g, S, E); }
            }
            if (type == ST_MLSTM) p_gates(P, hb_in, ss_in, (const float*)(ws + WS_WMG + (size_t)layer * WMG_SZ), inptr(P, 8) + layer * 8, (float*)(ws + WS_GATES));
            SEAM(pid0);
        }
        if (RUN(pid0 + 1) && slot_active(type, 1)) {
            PHASE_BEGIN;
#pragma unroll 1
            for (int rep = PROBE_REP_N * (((PROBE_REP == 1 && type == ST_MLSTM) || (PROBE_REP == 4 && type == ST_SB)) ? 1 : 0); rep >= 0; --rep) {
            if (rep != PROBE_REP_N * (((PROBE_REP == 1 && type == ST_MLSTM) || (PROBE_REP == 4 && type == ST_SB)) ? 1 : 0)) xcd_barrier(bar, P.tid);
            if (type == ST_MLSTM) p_mlstm_a(P, (const float*)(ws + WS_GATES), (const bf16*)(sc + SC_TOK), (const bf16*)(sc + SC_TR), (bf16*)(sc + SC_U), (float*)(ws + WS_CHS));
            else p_sbattn(P, (const bf16*)(sc + SC_Q), (const bf16*)(ws + WS_KVK), (const bf16*)(ws + WS_KVV), (bf16*)(sc + SC_OATT), (PROBE_REP == 4 && rep == 0) ? (1 << 20) : ((PROBE_REP == 4) ? PROBE_CAP : (1 << 20)));
            }
            SEAM(pid0 + 1);
        }
        if (RUN(pid0 + 2) && slot_active(type, 2)) {
            PHASE_BEGIN;
#pragma unroll 1
            for (int rep = 0; rep < 1 + PROBE_REP_N * ((PROBE_REP == 2) ? 1 : 0); ++rep) {
            if (rep) xcd_barrier(bar, P.tid);
            p_mlstm_b(P, (const bf16*)(sc + SC_U), (const float*)(ws + WS_CHS), (bf16*)(sc + SC_CST), (float*)(ws + WS_MPREV));
            }
            SEAM(pid0 + 2);
        }
        if (RUN(pid0 + 3) && slot_active(type, 3)) {
            PHASE_BEGIN;
#pragma unroll 1
            for (int rep = 0; rep < 1 + PROBE_REP_N * ((PROBE_REP == 3) ? 1 : 0); ++rep) {
            if (rep) xcd_barrier(bar, P.tid);
            p_mlstm_c(P, (const float*)(ws + WS_GATES), (const bf16*)(sc + SC_TOK), (const bf16*)(sc + SC_TR), (const bf16*)(sc + SC_CST), (const float*)(ws + WS_MPREV), inptr(P, 9) + (size_t)layer * (MH * DV), (bf16*)(sc + SC_HS));
            }
            SEAM(pid0 + 3);
        }
        if (RUN(pid0 + 4) && slot_active(type, 4)) {
            PHASE_BEGIN;
            pg8::Gemm g{nullptr, nullptr, M, D, D}; EpiRes E{RstdTab{nullptr, tab, 0}, hb_in, (bf16*)(ws + WS_LO), hb_out, ss_out, outp, 1.0f, nullptr, 0, (s == 15) ? 1 : 0};
            if (type == ST_FFN) { g.A = (const bf16*)(sc + SC_HID); g.Bt = (const bf16*)(ws + WS_WD + (size_t)wi * WD_SZ); g.K = DFF; E.alpha = 0.5f; }
            else if (type == ST_MLSTM) { g.A = (const bf16*)(sc + SC_HS); g.Bt = (const bf16*)(ws + WS_WMO + (size_t)layer * WDD_SZ); }
            else if (type == ST_SB) { g.A = (const bf16*)(sc + SC_OATT); g.Bt = (const bf16*)(ws + WS_WO + (size_t)(layer - 2) * WDD_SZ); }
            else { g.A = hb_in; g.Bt = (const bf16*)(ws + WS_WPG + (size_t)layer * WDD_SZ); E.rt.ss = ss_in; E.pj = (const bf16*)(ws + WS_PJ); E.mode = 1; }
            pg8::StaticOrder S; S.init(M, D, P.G, (int)blockIdx.x, (type == ST_FFN) ? WGM_DN : WGM_RES);
            GEMM_PHASE(EpiRes, g, S, E);
            SEAM(pid0 + 4);
        }
    }
#undef SEAM
#undef RUN
}


#ifndef PROBE_FLAGS
#define PROBE_FLAGS 0
#endif
#ifndef PROBE_DUP
#define PROBE_DUP 0
#endif
static int pid_group(int pid) {
    if (pid == PID_PRO) return 1;
    const int s = (pid - PID_S0) >> 3, slot = (pid - PID_S0) & 7, type = stage_type(s);
    if (slot == 4) return PROBE_DUP >= 9 ? 0 : (type == ST_FFN ? 3 : 7);
    if (slot == 0 && PROBE_DUP >= 9) return (type == ST_SB) ? 13 : 0;
    if (slot == 0 && PROBE_DUP < 9) return type == ST_FFN ? 2 : (type == ST_MLSTM ? 4 : (type == ST_SB ? 6 : 8));
    if (PROBE_DUP >= 9) return type == ST_MLSTM ? 8 + slot : (slot == 1 ? 12 : 0);
    return type == ST_MLSTM ? 5 : 6;
}
static bool pid_active(int pid) {
    if (pid == PID_PRO) return true;
    if (pid < PID_S0 || pid >= PID_END) return false;
    const int s = (pid - PID_S0) >> 3, slot = (pid - PID_S0) & 7;
    return slot < 5 && slot_active(stage_type(s), slot);
}

extern "C" void kernel_launch(void* const* d_in, const int* in_sizes, int n_in, void* d_out, int out_size, void* d_ws, size_t ws_size, hipStream_t stream) {
    constexpr HostPlan plan = PLAN;
    static_assert((TIER_FFN == TIER_MLSTM) && (TIER_FFN == TIER_SB) && (TIER_FFN == TIER_PLE), "the residual stream of the F tier is two bf16 planes: the tiers can no longer be mixed");
    static int grid = 0;
    if (n_in != 20 || out_size != M * D || in_sizes[0] != M * D) { fprintf(stderr, "kernel_launch: unexpected shapes\n"); return; }
    if (ws_size < plan.total) { fprintf(stderr, "kernel_launch: workspace too small (%zu < %zu)\n", ws_size, plan.total); return; }
    const bool anyF = TIER_FFN || TIER_MLSTM || TIER_SB || TIER_PLE;
    if (grid == 0 && anyF) {
        int dev = 0, cus = 0, per_cu = 0;
        if (hipGetDevice(&dev) != hipSuccess || hipDeviceGetAttribute(&cus, hipDeviceAttributeMultiprocessorCount, dev) != hipSuccess) { fprintf(stderr, "kernel_launch: device query failed\n"); grid = -1; return; }
        if (hipFuncSetAttribute((const void*)fwd, hipFuncAttributeMaxDynamicSharedMemorySize, LDS_BYTES) != hipSuccess) { fprintf(stderr, "kernel_launch: hipFuncSetAttribute failed\n"); grid = -1; return; }
        if (hipOccupancyMaxActiveBlocksPerMultiprocessor(&per_cu, (const void*)fwd, NWAVES * 64, LDS_BYTES) != hipSuccess || per_cu < 1) { fprintf(stderr, "kernel_launch: occupancy query says %d blocks per CU\n", per_cu); }
        (void)hipGetLastError();
        grid = cus;
    }
    if (grid < 0) return;
    Inputs in; const float** ip = (const float**)&in;
    for (int i = 0; i < 20; ++i) ip[i] = (const float*)d_in[i];
    float* h = (float*)d_out; unsigned char* ws = (unsigned char*)d_ws;
    float* s_hn = (float*)(ws + plan.s_hn); float* s_t = (float*)(ws + plan.s_t); float* s_kvb = (float*)(ws + plan.s_kv);
    if (anyF) (void)hipMemsetAsync(ws + plan.m.ctl, 0, CTL_BYTES, stream);
    int bar_region = 0, cur = 0; bool hb_valid = false;
    int flo = -1, fhi = -1, fcur = 0;
    auto launchF = [&](int lo, int hi, int last, int cur_lo, bool junk = false, bool probe_launch = false) {
        Args a{};
        for (int i = 0; i < 20; ++i) a.in[i] = (const float*)d_in[i];
        a.out = junk ? (float*)(ws + plan.m.scratch + ((stage_type((lo - PID_S0) >> 3) == ST_MLSTM) ? 0 : (size_t)200 * 1024 * 1024)) : h; a.ws = ws; a.ph_lo = lo; a.ph_hi = hi; a.ph_last = last; a.bar_region = bar_region; a.cur_lo = cur_lo; a.kv_in_ffn = (TIER_SB && TIER_FFN) ? 1 : 0; a.pad0 = 0; a.pad1 = 0;
        hipLaunchKernelGGL(fwd, dim3(grid), dim3(NWAVES * 64), LDS_BYTES, stream, a);
        bar_region = (bar_region + 1) % 48;
    };
    auto flushF = [&]() {
        if (flo < 0) return;
        if (F_PER_PHASE) {
            for (int pid = flo; pid < fhi; ++pid) if (pid_active(pid)) { const int s = pid >= PID_S0 ? (pid - PID_S0) >> 3 : 0; const int s0 = flo >= PID_S0 ? (flo - PID_S0) >> 3 : 0; const int pc = s >= 16 ? fcur : ((fcur + (s - s0)) & 1); if (PROBE_DUP && pid_group(pid) == PROBE_DUP) launchF(pid, pid + 1, pid, pc, ((pid - PID_S0) & 7) == 4 && pid >= PID_S0, true); launchF(pid, pid + 1, pid, pc); }
        } else {
            int last = flo; for (int pid = flo; pid < fhi; ++pid) if (pid_active(pid)) last = pid;
            launchF(flo, fhi, last, fcur);
        }
        flo = -1; fhi = -1;
    };
    auto ensure_sync = [&]() {
        if (!hb_valid) { hipLaunchKernelGGL(k_f_sync, dim3(1024), dim3(256), 0, stream, (const float*)h, (bf16*)(ws + plan.m.hb) + (size_t)cur * ((size_t)M * D), (bf16*)(ws + plan.m.lo), (float*)(ws + plan.m.ss) + (size_t)cur * ((size_t)M * 32)); hb_valid = true; }
    };
    if (anyF) { flo = PID_PRO; fhi = PID_PRO + 1; fcur = 0; cur = 0; hb_valid = true; }
    else hipLaunchKernelGGL(k_s_copy, dim3(2048), dim3(256), 0, stream, h, in.x, (size_t)M * D / 4);
    for (int s = 0; s < 16; ++s) {
        const int type = stage_type(s), layer = s >> 2, k = s & 3;
        const bool tierF = type == ST_FFN ? TIER_FFN : (type == ST_MLSTM ? TIER_MLSTM : (type == ST_SB ? TIER_SB : TIER_PLE));
        if (s == 8) {
            if (TIER_SB) { if (!TIER_FFN) { flushF(); ensure_sync(); flo = PID_KVONLY; fhi = PID_KVONLY + 1; fcur = cur; flushF(); } }
            else { flushF(); s_kv(stream, in, h, s_hn, s_kvb); }
        }
        if (tierF) {
            if (flo < 0) { ensure_sync(); flo = PID_S0 + 8 * s; fcur = cur; }
            fhi = PID_S0 + 8 * s + 8; cur ^= 1; hb_valid = true;
        } else {
            flushF();
            if (type == ST_FFN) s_ffn(stream, in, layer, k >> 1, h, s_hn, s_t);
            else if (type == ST_MLSTM) s_mlstm(stream, in, layer, h, s_hn, s_t);
            else if (type == ST_SB) s_sb(stream, in, layer - 2, layer, h, s_hn, s_t, s_kvb);
            else s_ple(stream, in, layer, h, s_hn, s_t);
            hb_valid = false;
        }
    }
    flushF();
}
```
